# Optimizing an MI355X kernel written in HIP

```python
import math
import jax, jax.numpy as jnp
from jax import lax
import numpy as np

D_MODEL = 2048
BATCH = 2
SEQ = 8192
DEPTH = 4

N_MIXERS = 3
ATTN_HEADS = 16
ATTN_HEAD_DIM = 128
DILATION_PATTERNS = ((128, 1), (512, 4), (2048, 16))
N_DIL = len(DILATION_PATTERNS)
ATTN_BLOCK = 128
SSM_CH = 16
SSM_GROUPS = D_MODEL // SSM_CH
SSM_STATE = 64
SSM_DT_MIN = 0.001
SSM_DT_MAX = 0.1
RWKV_HEAD_DIM = 64
RWKV_HEADS = D_MODEL // RWKV_HEAD_DIM
RWKV_DECAY_LORA = 96
RWKV_AAA_LORA = 96
RWKV_GATE_LORA = 256
RWKV_GN_EPS = RWKV_HEAD_DIM * 1e-5
D_FF = 4 * D_MODEL
NORM_EPS = 1e-5
N_ATTN_LAYERS = (DEPTH + 2) // 3
N_SSM_LAYERS = (DEPTH + 1) // 3
N_RWKV_LAYERS = DEPTH // 3

kernel_name = 'hybrid_dilated_attn_s5_rwkv7_trunk'


def rms_norm(x, g):
    xf = x.astype(jnp.float32)
    y = xf * lax.rsqrt(jnp.mean(xf * xf, axis=-1, keepdims=True) + NORM_EPS)
    return (y * g.astype(jnp.float32)).astype(x.dtype)


def alibi_slopes(n):
    return 2.0 ** (-8.0 * jnp.arange(1, n + 1, dtype=jnp.float32) / n)


def dilated_window_branch(q, k, v, slopes, dilation, lookback):
    b, s, h, e = q.shape
    L = s // dilation
    n = b * dilation
    nb = -(-L // ATTN_BLOCK)
    lp = nb * ATTN_BLOCK

    def to_sub(a):
        return a.reshape(b, L, dilation, h, e).transpose(0, 2, 1, 3, 4).reshape(n, L, h, e)

    qs = jnp.pad(to_sub(q), ((0, 0), (0, lp - L), (0, 0), (0, 0))).reshape(n, nb, ATTN_BLOCK, h, e)

    def windows(a):
        a = jnp.pad(to_sub(a), ((0, 0), (ATTN_BLOCK, lp - L), (0, 0), (0, 0)))
        a = a.reshape(n, nb + 1, ATTN_BLOCK, h, e)
        return jnp.concatenate([a[:, :-1], a[:, 1:]], axis=2)

    kw, vw = windows(k), windows(v)
    qi = jnp.arange(ATTN_BLOCK)[:, None]
    kj = jnp.arange(2 * ATTN_BLOCK)[None, :]
    dist = ATTN_BLOCK + qi - kj
    key_idx = jnp.arange(nb)[:, None, None] * ATTN_BLOCK + kj[None] - ATTN_BLOCK
    valid = (dist >= 0) & (dist <= lookback) & (key_idx >= 0)
    bias = -(slopes[:, None, None] * dilation) * dist.astype(jnp.float32)
    scores = jnp.einsum('nbqhe,nbkhe->nbhqk', qs, kw).astype(jnp.float32) * (e ** -0.5)
    scores = jnp.where(valid[None, :, None], scores + bias, -jnp.inf)
    m = jnp.max(scores, axis=-1, keepdims=True)
    p = jnp.exp(scores - m)
    denom = jnp.sum(p, axis=-1, keepdims=True)
    out = jnp.einsum('nbhqk,nbkhe->nbqhe', p / denom, vw.astype(jnp.float32))
    lse = jnp.transpose((m + jnp.log(denom))[..., 0], (0, 1, 3, 2))

    def from_sub(a):
        a = a.reshape((n, lp) + a.shape[3:])[:, :L]
        a = a.reshape((b, dilation, L) + a.shape[2:])
        a = jnp.swapaxes(a, 1, 2)
        return a.reshape((b, s) + a.shape[3:])

    return from_sub(out), from_sub(lse)


def dilated_attention(h, w_qkv, w_o):
    b, s, _ = h.shape
    w = w_qkv.reshape(D_MODEL, N_DIL, 3, ATTN_HEADS, ATTN_HEAD_DIM)
    slopes = alibi_slopes(N_DIL * ATTN_HEADS).reshape(N_DIL, ATTN_HEADS)
    outs, lses = [], []
    for g, (window, dilation) in enumerate(DILATION_PATTERNS):
        qkv = jnp.einsum('bsd,dthe->tbshe', h, w[:, g])
        o, l = dilated_window_branch(qkv[0], qkv[1], qkv[2], slopes[g], dilation, window // dilation)
        outs.append(o)
        lses.append(l)
    wts = jax.nn.softmax(jnp.stack(lses), axis=0)
    o = jnp.sum(wts[..., None] * jnp.stack(outs), axis=0)
    return o.reshape(b, s, ATTN_HEADS * ATTN_HEAD_DIM).astype(h.dtype) @ w_o


def s5_mixer(h, w_in, log_dt, a_re, a_im, b_re, b_im, c_re, c_im, d_skip, w_out):
    bsz, s, _ = h.shape
    f32 = jnp.float32
    u = (h @ w_in).reshape(bsz, s, SSM_GROUPS, SSM_CH).astype(f32)
    a_re = a_re.astype(f32)
    a_im = a_im.astype(f32)
    dt = jnp.exp(log_dt.astype(f32))[:, None]
    mag = jnp.exp(dt * a_re)
    ab_re = mag * jnp.cos(dt * a_im)
    ab_im = mag * jnp.sin(dt * a_im)
    den = a_re * a_re + a_im * a_im
    zr = ab_re - 1.0
    cr = (zr * a_re + ab_im * a_im) / den
    ci = (ab_im * a_re - zr * a_im) / den
    bb_re = cr[..., None] * b_re - ci[..., None] * b_im
    bb_im = cr[..., None] * b_im + ci[..., None] * b_re
    bu_re = jnp.einsum('bsgc,gpc->bsgp', u, bb_re)
    bu_im = jnp.einsum('bsgc,gpc->bsgp', u, bb_im)
    a_seq_re = jnp.broadcast_to(ab_re, (1, s, SSM_GROUPS, SSM_STATE))
    a_seq_im = jnp.broadcast_to(ab_im, (1, s, SSM_GROUPS, SSM_STATE))

    def combine(e1, e2):
        a1r, a1i, x1r, x1i = e1
        a2r, a2i, x2r, x2i = e2
        return (a2r * a1r - a2i * a1i, a2r * a1i + a2i * a1r,
                a2r * x1r - a2i * x1i + x2r, a2r * x1i + a2i * x1r + x2i)

    _, _, st_re, st_im = lax.associative_scan(combine, (a_seq_re, a_seq_im, bu_re, bu_im), axis=1)
    y = (jnp.einsum('bsgp,gcp->bsgc', st_re, c_re) - jnp.einsum('bsgp,gcp->bsgc', st_im, c_im)
         + d_skip * u)
    y = jax.nn.gelu(y.reshape(bsz, s, SSM_GROUPS * SSM_CH)).astype(h.dtype)
    z = y @ w_out
    return z[..., :D_MODEL] * jax.nn.sigmoid(z[..., D_MODEL:])


def rwkv7_mixer(h, mu, w_rkv, w0, w1, w2, a0, a1, a2, g1, g2, k_k, k_a, r_k, ln_w, ln_b, w_o):
    b, s, d = h.shape
    f32 = jnp.float32
    H, N = RWKV_HEADS, RWKV_HEAD_DIM
    xx = jnp.pad(h, ((0, 0), (1, 0), (0, 0)))[:, :-1] - h
    x_rkv = h[:, :, None, :] + xx[:, :, None, :] * mu[:3]
    xw = h + xx * mu[3]
    xa = h + xx * mu[4]
    xg = h + xx * mu[5]
    rkv = jnp.einsum('bsjd,jde->bsje', x_rkv, w_rkv)
    r, k, v = rkv[:, :, 0], rkv[:, :, 1], rkv[:, :, 2]
    w = -jax.nn.softplus(-(w0 + jnp.tanh(xw @ w1) @ w2).astype(f32)) - 0.5
    decay = jnp.exp(-jnp.exp(w))
    a = jax.nn.sigmoid((a0 + (xa @ a1) @ a2).astype(f32))
    g = jax.nn.sigmoid(xg @ g1) @ g2
    heads = lambda t: t.astype(f32).reshape(b, s, H, N)
    r, k, v, decay, a = heads(r), heads(k), heads(v), heads(decay), heads(a)
    kk = k * k_k.astype(f32).reshape(H, N)
    kk = kk / jnp.maximum(jnp.sqrt(jnp.sum(kk * kk, axis=-1, keepdims=True)), 1e-12)
    k = k * (1.0 + (a - 1.0) * k_a.astype(f32).reshape(H, N))

    def step(state, inp):
        r_t, w_t, k_t, v_t, a_t, b_t = inp
        sa = jnp.einsum('bhvk,bhk->bhv', state, a_t)
        state = (state * w_t[:, :, None, :] + sa[..., None] * b_t[:, :, None, :]
                 + v_t[..., None] * k_t[:, :, None, :])
        return state, jnp.einsum('bhvk,bhk->bhv', state, r_t)

    tm = lambda t: jnp.moveaxis(t, 1, 0)
    s0 = jnp.zeros((b, H, N, N), f32)
    _, y = lax.scan(step, s0, (tm(r), tm(decay), tm(k), tm(v), tm(-kk), tm(kk * a)))
    y = jnp.moveaxis(y, 0, 1)
    mean = jnp.mean(y, axis=-1, keepdims=True)
    var = jnp.mean(jnp.square(y - mean), axis=-1, keepdims=True)
    y = ((y - mean) * lax.rsqrt(var + RWKV_GN_EPS)).reshape(b, s, d) * ln_w + ln_b
    bonus = jnp.sum(r * k * r_k.astype(f32), axis=-1, keepdims=True) * v
    y = y + bonus.reshape(b, s, d)
    return (y * g).astype(h.dtype) @ w_o


def squared_relu_mlp(h, w1, w2):
    return jnp.square(jax.nn.relu(h @ w1)) @ w2


def setup_inputs(seed: int = 0) -> dict:
    key = jax.random.key(seed)
    ks = jax.random.split(key, 40)
    f32 = jnp.float32

    def nrm(i, shape, scale=1.0):
        return jax.random.normal(ks[i], shape, f32) * scale

    D = D_MODEL
    HE = ATTN_HEADS * ATTN_HEAD_DIM
    G, C, P = SSM_GROUPS, SSM_CH, SSM_STATE
    NA, NB, NC = N_ATTN_LAYERS, N_SSM_LAYERS, N_RWKV_LAYERS
    return {
        'x': nrm(0, (BATCH, SEQ, D)),
        'norm_mix': 1.0 + nrm(1, (DEPTH, D), 0.02),
        'norm_mlp': 1.0 + nrm(2, (DEPTH, D), 0.02),
        'norm_f': 1.0 + nrm(3, (D,), 0.02),
        'attn_w_qkv': nrm(4, (NA, D, N_DIL * 3 * HE), D ** -0.5),
        'attn_w_o': nrm(5, (NA, HE, D), HE ** -0.5),
        'ssm_w_in': nrm(6, (NB, D, G * C), D ** -0.5),
        'ssm_log_dt': jax.random.uniform(ks[7], (NB, G), f32, math.log(SSM_DT_MIN), math.log(SSM_DT_MAX)),
        'ssm_a_re': -0.5 + nrm(8, (NB, G, P), 0.01),
        'ssm_a_im': jnp.pi * jnp.arange(P, dtype=f32) + nrm(9, (NB, G, P), 0.01),
        'ssm_b_re': nrm(10, (NB, G, P, C), (2 * C) ** -0.5),
        'ssm_b_im': nrm(11, (NB, G, P, C), (2 * C) ** -0.5),
        'ssm_c_re': nrm(12, (NB, G, C, P), 1.0),
        'ssm_c_im': nrm(13, (NB, G, C, P), 1.0),
        'ssm_d': nrm(14, (NB, G, C)),
        'ssm_w_out': nrm(15, (NB, G * C, 2 * D), (G * C) ** -0.5),
        'rwkv_mu': jax.random.uniform(ks[16], (NC, 6, D), f32),
        'rwkv_w_rkv': nrm(17, (NC, 3, D, D), D ** -0.5),
        'rwkv_w0': jax.random.uniform(ks[18], (NC, D), f32, -6.0, 1.0),
        'rwkv_w1': nrm(19, (NC, D, RWKV_DECAY_LORA), D ** -0.5),
        'rwkv_w2': nrm(20, (NC, RWKV_DECAY_LORA, D), 0.1 * RWKV_DECAY_LORA ** -0.5),
        'rwkv_a0': nrm(21, (NC, D), 0.1),
        'rwkv_a1': nrm(22, (NC, D, RWKV_AAA_LORA), D ** -0.5),
        'rwkv_a2': nrm(23, (NC, RWKV_AAA_LORA, D), 0.1 * RWKV_AAA_LORA ** -0.5),
        'rwkv_g1': nrm(24, (NC, D, RWKV_GATE_LORA), D ** -0.5),
        'rwkv_g2': nrm(25, (NC, RWKV_GATE_LORA, D), RWKV_GATE_LORA ** -0.5),
        'rwkv_k_k': 0.85 + nrm(26, (NC, D), 0.02),
        'rwkv_k_a': 1.0 + nrm(27, (NC, D), 0.02),
        'rwkv_r_k': nrm(28, (NC, RWKV_HEADS, RWKV_HEAD_DIM), 0.1),
        'rwkv_ln_w': 1.0 + nrm(29, (NC, D), 0.02),
        'rwkv_ln_b': nrm(30, (NC, D), 0.02),
        'rwkv_w_o': nrm(31, (NC, D, D), D ** -0.5),
        'mlp_w1': nrm(32, (DEPTH, D, D_FF), D ** -0.5),
        'mlp_w2': nrm(33, (DEPTH, D_FF, D), D_FF ** -0.5),
    }


def reference(x, norm_mix, norm_mlp, norm_f, attn_w_qkv, attn_w_o, ssm_w_in, ssm_log_dt,
              ssm_a_re, ssm_a_im, ssm_b_re, ssm_b_im, ssm_c_re, ssm_c_im, ssm_d, ssm_w_out,
              rwkv_mu, rwkv_w_rkv, rwkv_w0, rwkv_w1, rwkv_w2, rwkv_a0, rwkv_a1, rwkv_a2,
              rwkv_g1, rwkv_g2, rwkv_k_k, rwkv_k_a, rwkv_r_k, rwkv_ln_w, rwkv_ln_b, rwkv_w_o,
              mlp_w1, mlp_w2):
    ia = ib = ic = 0
    for layer in range(DEPTH):
        h = rms_norm(x, norm_mix[layer])
        kind = layer % N_MIXERS
        if kind == 0:
            mix = dilated_attention(h, attn_w_qkv[ia], attn_w_o[ia])
            ia += 1
        elif kind == 1:
            mix = s5_mixer(h, ssm_w_in[ib], ssm_log_dt[ib], ssm_a_re[ib], ssm_a_im[ib],
                           ssm_b_re[ib], ssm_b_im[ib], ssm_c_re[ib], ssm_c_im[ib],
                           ssm_d[ib], ssm_w_out[ib])
            ib += 1
        else:
            mix = rwkv7_mixer(h, rwkv_mu[ic], rwkv_w_rkv[ic], rwkv_w0[ic], rwkv_w1[ic], rwkv_w2[ic],
                              rwkv_a0[ic], rwkv_a1[ic], rwkv_a2[ic], rwkv_g1[ic], rwkv_g2[ic],
                              rwkv_k_k[ic], rwkv_k_a[ic], rwkv_r_k[ic], rwkv_ln_w[ic],
                              rwkv_ln_b[ic], rwkv_w_o[ic])
            ic += 1
        x = x + mix
        x = x + squared_relu_mlp(rms_norm(x, norm_mlp[layer]), mlp_w1[layer], mlp_w2[layer])
    return rms_norm(x, norm_f)
```

```cpp
#include <hip/hip_runtime.h>
#include <cstdio>
#include <cstdint>

#ifndef MK_N_LAUNCHES
#define MK_N_LAUNCHES 1
#endif

#ifndef PROBE_DUP
#define PROBE_DUP 0
#endif
#define REP(bit) for (int rep_ = 0; rep_ < ((PROBE_DUP >> (bit)) & 1) + 1; ++rep_)
#define LAS __attribute__((address_space(3)))
#define GAS __attribute__((address_space(1)))
typedef unsigned short bf16;
typedef short bf16x8 __attribute__((ext_vector_type(8)));
typedef short s16x4 __attribute__((ext_vector_type(4)));
typedef float f32x4 __attribute__((ext_vector_type(4)));
typedef float f32x2 __attribute__((ext_vector_type(2)));
typedef unsigned u32x4 __attribute__((ext_vector_type(4)));
typedef unsigned u32x2 __attribute__((ext_vector_type(2)));

constexpr int BATCH = 2, SEQ = 8192, DM = 2048, FF = 8192, DEPTH = 4;
constexpr int M = BATCH * SEQ;
constexpr int NQKV = 18432;
constexpr int NRW1 = 6912;
constexpr float NORM_EPS = 1e-5f;
constexpr int NWAVES = 8;

__device__ __forceinline__ float frcp(float x) { return __builtin_amdgcn_rcpf(x); }

namespace pg8 {
constexpr int BM = 256, BK = 64, HALF = 128, HTB = HALF * BK * 2, STAGE_BYTES = 8 * HTB, NXCD = 8, WGM = 8;
__host__ __device__ __forceinline__ int lds_byte(int r, int c) { const int st = (r >> 4) * 2 + (c >> 5), rr = r & 15, cc = c & 31, ob = rr * 64 + cc * 2; return st * 1024 + (ob ^ (((ob >> 9) & 1) << 5)); }
__host__ __device__ __forceinline__ void stage_rc(int b, int& R, int& C) { const int st = b / 1024, sb = b % 1024, swz = sb ^ (((sb >> 9) & 1) << 5); R = (st >> 1) * 16 + swz / 64; C = (st & 1) * 32 + (swz % 64) / 2; }
__host__ __device__ __forceinline__ int perm32(int rho) { const int n = rho >> 4, i = rho & 15; return 8 * (i >> 2) + 4 * n + (i & 3); }

struct Unit { int pm, pn; };
struct Gemm { const bf16* A; const bf16* Bt; int M, N, K, lda, ldb; };

struct StaticOrder {
    int nM, nN, nwg, G, c;
    __device__ void init(int M_, int N_, int G_, int c_) { nM = M_ / BM; nN = N_ / BM; nwg = nM * nN; G = G_; c = c_; }
    __device__ bool next(int i, Unit& u) const {
        const long L = (long)i * G + c; if (L >= nwg) return false;
        int wgid = (int)L; { const int q = nwg / NXCD, r = nwg % NXCD, xcd = wgid % NXCD, off = wgid / NXCD; wgid = (xcd < r ? xcd * (q + 1) : r * (q + 1) + (xcd - r) * q) + off; }
        const int nig = WGM * nN, gid = wgid / nig, fm = gid * WGM, gsz = (nM - fm) < WGM ? (nM - fm) : WGM;
        u.pm = fm + ((wgid % nig) % gsz); u.pn = (wgid % nig) / gsz; return true;
    }
    __device__ __forceinline__ size_t a_off(const Unit&) const { return 0; }
};
struct RwkvOrder : StaticOrder {
    __device__ __forceinline__ size_t a_off(const Unit& u) const { const int idx = u.pn < 24 ? (u.pn >> 3) : (u.pn - 21); return (size_t)idx * ((size_t)M * DM * 2); }
};
__device__ __forceinline__ unsigned cvt_pk_bf16(float lo, float hi) { unsigned r; asm volatile("v_cvt_pk_bf16_f32 %0, %1, %2" : "=v"(r) : "v"(lo), "v"(hi)); return r; }

typedef f32x4 Acc[2][2][4][2];

typedef unsigned long long ssq_t;
__device__ __forceinline__ float row_rstd(const ssq_t* ssq, int row) { return ssq ? 1.f / sqrtf((float)ssq[row] * (1.f / 1048576.f) * (1.f / DM) + NORM_EPS) : 1.f; }
struct RstdTab { const ssq_t* ssq; LAS float* tab; int pm0; };
__device__ __forceinline__ RstdTab rstd_prepare(const ssq_t* ssq, LAS unsigned char* lds, int pm0, int tid) {
    RstdTab t; t.ssq = ssq; t.tab = (LAS float*)(lds + STAGE_BYTES); t.pm0 = pm0;
    if (ssq && tid < 256) t.tab[tid] = row_rstd(ssq, pm0 * BM + tid);
    return t;
}
__device__ __forceinline__ float rstd_get(const RstdTab& t, int pm, int rloc) { return !t.ssq ? 1.f : (pm == t.pm0 ? t.tab[rloc] : row_rstd(t.ssq, pm * BM + rloc)); }
__device__ __forceinline__ u32x4 to_store_layout(const u32x4 w, int lane) {
    const int src = (((lane & 3) << 4) | (lane >> 2)) << 2; u32x4 o;
    o.x = (unsigned)__builtin_amdgcn_ds_bpermute(src, (int)w.x); o.y = (unsigned)__builtin_amdgcn_ds_bpermute(src, (int)w.y);
    o.z = (unsigned)__builtin_amdgcn_ds_bpermute(src, (int)w.z); o.w = (unsigned)__builtin_amdgcn_ds_bpermute(src, (int)w.w); return o;
}
template <int ACT  > struct EpiBf16 {
    static constexpr bool PERM = true, PREP = true;
    bf16* O; int ldc; const ssq_t* ssq; RstdTab rt;
    __device__ __forceinline__ void prep(LAS unsigned char* lds, int pm0, int tid) { rt = rstd_prepare(ssq, lds, pm0, tid); }
    __device__ __forceinline__ void operator()(const Acc& acc, const Unit& u, int wr, int wc, int fr, int fq) const {
        const int lane = fq * 16 + fr, sr = lane >> 2, sq = lane & 3;
        const int row0 = u.pm * BM + wr * 64 + sr, col0 = u.pn * BM + wc * 32 + 8 * sq;
#pragma unroll
        for (int ai = 0; ai < 2; ++ai)
#pragma unroll
            for (int m = 0; m < 4; ++m) { bf16* rowp = O + (size_t)(row0 + ai * HALF + m * 16) * ldc + col0; const float rs = rstd_get(rt, u.pm, wr * 64 + fr + ai * HALF + m * 16);
#pragma unroll
                for (int bj = 0; bj < 2; ++bj) { f32x4 v0 = acc[ai][bj][m][0] * rs, v1 = acc[ai][bj][m][1] * rs;
                    if (ACT == 1) { const f32x4 z4 = (f32x4){0.f, 0.f, 0.f, 0.f};
                        const f32x4 m0 = __builtin_elementwise_max(v0, z4), m1 = __builtin_elementwise_max(v1, z4); v0 = m0 * m0; v1 = m1 * m1; }
                    u32x4 w; w.x = cvt_pk_bf16(v0[0], v0[1]); w.y = cvt_pk_bf16(v0[2], v0[3]); w.z = cvt_pk_bf16(v1[0], v1[1]); w.w = cvt_pk_bf16(v1[2], v1[3]);
                    *(u32x4*)(rowp + bj * HALF) = to_store_layout(w, lane); } }
    }
};
__device__ __forceinline__ void row_ssq_add(ssq_t* ssq, int row, float s, int fq) {
    s += __shfl_xor(s, 16); s += __shfl_xor(s, 32);
    if (fq == 0) atomicAdd(ssq + row, (ssq_t)(s * 1048576.f));
}
__device__ __forceinline__ float sq8(const u32x4 w) { float s = 0.f;
#pragma unroll
    for (int j = 0; j < 4; ++j) { const float lo = __builtin_bit_cast(float, w[j] << 16), hi = __builtin_bit_cast(float, w[j] & 0xffff0000u); s += lo * lo + hi * hi; } return s; }
template <bool RF32> struct EpiResB {
    static constexpr bool PERM = true, PREP = false;
    const void* resid; bf16* out; ssq_t* ssq;
    __device__ __forceinline__ void operator()(const Acc& acc, const Unit& u, int wr, int wc, int fr, int fq) const {
        const int row0 = u.pm * BM + wr * 64 + fr, col0 = u.pn * BM + wc * 32 + 8 * fq;
        f32x4 rf[2][4]; u32x4 rb[2][2]; float ssum[8];
#define RES_LOAD(i_, b_) do { const size_t off_ = (size_t)(row0 + ((i_) >> 2) * HALF + ((i_) & 3) * 16) * DM + col0; \
            if (RF32) { rf[b_][0] = *(const f32x4*)((const float*)resid + off_); rf[b_][1] = *(const f32x4*)((const float*)resid + off_ + 4); \
                        rf[b_][2] = *(const f32x4*)((const float*)resid + off_ + HALF); rf[b_][3] = *(const f32x4*)((const float*)resid + off_ + HALF + 4); } \
            else { rb[b_][0] = *(const u32x4*)((const bf16*)resid + off_); rb[b_][1] = *(const u32x4*)((const bf16*)resid + off_ + HALF); } } while (0)
        RES_LOAD(0, 0);
#pragma unroll
        for (int i = 0; i < 8; ++i) { const int ai = i >> 2, m = i & 3, b = i & 1; const size_t off = (size_t)(row0 + ai * HALF + m * 16) * DM + col0; float s = 0.f;
            if (i + 1 < 8) { if (b == 0) RES_LOAD(i + 1, 1); else RES_LOAD(i + 1, 0); }
#pragma unroll
            for (int bj = 0; bj < 2; ++bj) { f32x4 r0, r1;
                if (RF32) { r0 = rf[b][2 * bj]; r1 = rf[b][2 * bj + 1]; }
                else { const u32x4 rw = rb[b][bj];
                    r0 = (f32x4){__builtin_bit_cast(float, rw[0] << 16), __builtin_bit_cast(float, rw[0] & 0xffff0000u), __builtin_bit_cast(float, rw[1] << 16), __builtin_bit_cast(float, rw[1] & 0xffff0000u)};
                    r1 = (f32x4){__builtin_bit_cast(float, rw[2] << 16), __builtin_bit_cast(float, rw[2] & 0xffff0000u), __builtin_bit_cast(float, rw[3] << 16), __builtin_bit_cast(float, rw[3] & 0xffff0000u)}; }
                const f32x4 o0 = r0 + acc[ai][bj][m][0], o1 = r1 + acc[ai][bj][m][1];
                u32x4 w; w.x = cvt_pk_bf16(o0[0], o0[1]); w.y = cvt_pk_bf16(o0[2], o0[3]); w.z = cvt_pk_bf16(o1[0], o1[1]); w.w = cvt_pk_bf16(o1[2], o1[3]);
                *(u32x4*)(out + off + bj * HALF) = w; s += sq8(w); }
            s += __shfl_xor(s, 16); s += __shfl_xor(s, 32); ssum[i] = s; }
#undef RES_LOAD
        if (fq == 0) {
#pragma unroll
            for (int i = 0; i < 8; ++i) atomicAdd(ssq + row0 + (i >> 2) * HALF + (i & 3) * 16, (ssq_t)(ssum[i] * 1048576.f)); }
    }
};
struct EpiGluRes {
    static constexpr bool PERM = true, PREP = false;
    bf16* out; ssq_t* ssq;
    __device__ __forceinline__ void operator()(const Acc& acc, const Unit& u, int wr, int wc, int fr, int fq) const {
        const int row0 = u.pm * BM + wr * 64 + fr, col0 = u.pn * HALF + wc * 32 + 8 * fq;
        u32x4 rb[2]; float ssum[8];
        rb[0] = *(const u32x4*)(out + (size_t)row0 * DM + col0);
#pragma unroll
        for (int i = 0; i < 8; ++i) { const int ai = i >> 2, m = i & 3; const int row = row0 + ai * HALF + m * 16; const size_t off = (size_t)row * DM + col0;
                if (i + 1 < 8) rb[(i + 1) & 1] = *(const u32x4*)(out + (size_t)(row0 + ((i + 1) >> 2) * HALF + ((i + 1) & 3) * 16) * DM + col0);
                const u32x4 rw = rb[i & 1]; float r[8], o[8];
#pragma unroll
                for (int j = 0; j < 4; ++j) { r[2 * j] = __builtin_bit_cast(float, rw[j] << 16); r[2 * j + 1] = __builtin_bit_cast(float, rw[j] & 0xffff0000u); }
#pragma unroll
                for (int n = 0; n < 2; ++n)
#pragma unroll
                    for (int j = 0; j < 4; ++j) { const float v = acc[ai][0][m][n][j], g = acc[ai][1][m][n][j]; o[4 * n + j] = r[4 * n + j] + v * frcp(1.f + __expf(-g)); }
                u32x4 w; w.x = cvt_pk_bf16(o[0], o[1]); w.y = cvt_pk_bf16(o[2], o[3]); w.z = cvt_pk_bf16(o[4], o[5]); w.w = cvt_pk_bf16(o[6], o[7]);
                *(u32x4*)(out + off) = w; float s = sq8(w); s += __shfl_xor(s, 16); s += __shfl_xor(s, 32); ssum[i] = s; }
        if (fq == 0) {
#pragma unroll
            for (int i = 0; i < 8; ++i) atomicAdd(ssq + row0 + (i >> 2) * HALF + (i & 3) * 16, (ssq_t)(ssum[i] * 1048576.f)); }
    }
};
struct EpiS5U16 {
    static constexpr bool PERM = true, PREP = true;
    bf16* U16; const ssq_t* ssq; RstdTab rt;
    __device__ __forceinline__ void prep(LAS unsigned char* lds, int pm0, int tid) { rt = rstd_prepare(ssq, lds, pm0, tid); }
    __device__ __forceinline__ void operator()(const Acc& acc, const Unit& u, int wr, int wc, int fr, int fq) const {
        const int row0 = u.pm * BM + wr * 64 + fr, col0 = u.pn * BM + wc * 32 + 8 * fq;
#pragma unroll
        for (int ai = 0; ai < 2; ++ai)
#pragma unroll
            for (int m = 0; m < 4; ++m) { const int row = row0 + ai * HALF + m * 16, b = row >> 13, t = row & 8191; const float rs = rstd_get(rt, u.pm, wr * 64 + fr + ai * HALF + m * 16);
#pragma unroll
                for (int bj = 0; bj < 2; ++bj) { const int col = col0 + bj * HALF, g = col >> 4, c0 = col & 15; const f32x4 v0 = acc[ai][bj][m][0] * rs, v1 = acc[ai][bj][m][1] * rs;
                    u32x4 w; w.x = cvt_pk_bf16(v0[0], v0[1]); w.y = cvt_pk_bf16(v0[2], v0[3]); w.z = cvt_pk_bf16(v1[0], v1[1]); w.w = cvt_pk_bf16(v1[2], v1[3]);
                    *(u32x4*)(U16 + ((((size_t)(b * 128 + g) * 512 + (t >> 4)) * 512) + (t & 15) * 16 + c0)) = w; } }
    }
};
struct EpiS5F {
    static constexpr bool PERM = false, PREP = false;
    float* X;
    __device__ __forceinline__ void operator()(const Acc& acc, const Unit& u, int wr, int wc, int fr, int fq) const {
        const int row0 = u.pm * BM + wr * 64 + fr, col0 = wc * 32 + 4 * fq;
#pragma unroll
        for (int ai = 0; ai < 2; ++ai)
#pragma unroll
            for (int m = 0; m < 4; ++m)
#pragma unroll
                for (int n = 0; n < 2; ++n) *(f32x4*)(X + (size_t)(row0 + ai * HALF + m * 16) * 128 + col0 + n * 16) = acc[ai][0][m][n];
    }
};
__device__ __forceinline__ float gelu_tanh_e(float y) { const float z = 0.7978845608028654f * (y + 0.044715f * y * y * y); const float t = 1.f - 2.f * frcp(__expf(2.f * z) + 1.f); return 0.5f * y * (1.f + t); }
struct EpiS5Y {
    static constexpr bool PERM = true, PREP = false;
    bf16* YS;
    __device__ __forceinline__ void operator()(const Acc& acc, const Unit& u, int wr, int wc, int fr, int fq) const {
        const int b = u.pm >> 8, g = (u.pm >> 1) & 127, chunk0 = (u.pm & 1) * 256 + wr * 64 + fr, col0 = wc * 32 + 8 * fq;
#pragma unroll
        for (int ai = 0; ai < 2; ++ai)
#pragma unroll
            for (int m = 0; m < 4; ++m) { const int chunk = chunk0 + ai * HALF + m * 16;
#pragma unroll
                for (int bj = 0; bj < 2; ++bj) { const int col = col0 + bj * HALF, tt = col >> 4, c0 = col & 15; f32x4 v0 = acc[ai][bj][m][0], v1 = acc[ai][bj][m][1];
#pragma unroll
                    for (int j = 0; j < 4; ++j) { v0[j] = gelu_tanh_e(v0[j]); v1[j] = gelu_tanh_e(v1[j]); }
                    u32x4 w; w.x = cvt_pk_bf16(v0[0], v0[1]); w.y = cvt_pk_bf16(v0[2], v0[3]); w.z = cvt_pk_bf16(v1[0], v1[1]); w.w = cvt_pk_bf16(v1[2], v1[3]);
                    *(u32x4*)(YS + ((size_t)b * 8192 + chunk * 16 + tt) * DM + 16 * g + c0) = w; } }
    }
};
struct PairOrder {
    int pair;
    __device__ bool next(int i, Unit& u) const { if (i >= 2) return false; u.pm = 2 * pair + i; u.pn = pair & 127; return true; }
    __device__ __forceinline__ size_t a_off(const Unit&) const { return 0; }
};
struct EpiRwkv1 {
    static constexpr bool PERM = true, PREP = false;
    bf16* RKV; bf16* LORA;
    __device__ __forceinline__ void operator()(const Acc& acc, const Unit& u, int wr, int wc, int fr, int fq) const {
        const int lane = fq * 16 + fr, sr = lane >> 2, sq = lane & 3;
        const int row0 = u.pm * BM + wr * 64 + sr; const int pn = u.pn;
        bf16* base; int ldc, colt, act;
        if (pn < 24) { base = RKV + (size_t)(pn >> 3) * ((size_t)M * DM); ldc = DM; colt = (pn & 7) * BM; act = 0; }
        else { base = LORA; ldc = 768; colt = (pn - 24) * BM; act = pn - 23; }
        const int col0 = colt + wc * 32 + 8 * sq;
#pragma unroll
        for (int ai = 0; ai < 2; ++ai)
#pragma unroll
            for (int m = 0; m < 4; ++m) { bf16* rowp = base + (size_t)(row0 + ai * HALF + m * 16) * ldc + col0;
#pragma unroll
                for (int bj = 0; bj < 2; ++bj) { f32x4 v0 = acc[ai][bj][m][0], v1 = acc[ai][bj][m][1];
                    if (act == 1) {
#pragma unroll
                        for (int j = 0; j < 4; ++j) { v0[j] = 1.f - 2.f * frcp(__expf(2.f * v0[j]) + 1.f); v1[j] = 1.f - 2.f * frcp(__expf(2.f * v1[j]) + 1.f); } }
                    else if (act == 3) {
#pragma unroll
                        for (int j = 0; j < 4; ++j) { v0[j] = frcp(1.f + __expf(-v0[j])); v1[j] = frcp(1.f + __expf(-v1[j])); } }
                    u32x4 w; w.x = cvt_pk_bf16(v0[0], v0[1]); w.y = cvt_pk_bf16(v0[2], v0[3]); w.z = cvt_pk_bf16(v1[0], v1[1]); w.w = cvt_pk_bf16(v1[2], v1[3]);
                    *(u32x4*)(rowp + bj * HALF) = to_store_layout(w, lane); } }
    }
};
struct EpiSigBf16 {
    static constexpr bool PERM = true, PREP = false;
    bf16* O; int ldc; const float* bias;
    __device__ __forceinline__ void operator()(const Acc& acc, const Unit& u, int wr, int wc, int fr, int fq) const {
        const int lane = fq * 16 + fr, sr = lane >> 2, sq = lane & 3;
        const int row0 = u.pm * BM + wr * 64 + sr, col0 = u.pn * BM + wc * 32 + 8 * sq, cola = u.pn * BM + wc * 32 + 8 * fq;
        f32x4 b0[2], b1[2];
#pragma unroll
        for (int bj = 0; bj < 2; ++bj) { b0[bj] = *(const f32x4*)(bias + cola + bj * HALF); b1[bj] = *(const f32x4*)(bias + cola + bj * HALF + 4); }
#pragma unroll
        for (int ai = 0; ai < 2; ++ai)
#pragma unroll
            for (int m = 0; m < 4; ++m) { bf16* rowp = O + (size_t)(row0 + ai * HALF + m * 16) * ldc + col0;
#pragma unroll
                for (int bj = 0; bj < 2; ++bj) { f32x4 v0 = acc[ai][bj][m][0] + b0[bj], v1 = acc[ai][bj][m][1] + b1[bj];
#pragma unroll
                    for (int j = 0; j < 4; ++j) { v0[j] = frcp(1.f + __expf(-v0[j])); v1[j] = frcp(1.f + __expf(-v1[j])); }
                    u32x4 w; w.x = cvt_pk_bf16(v0[0], v0[1]); w.y = cvt_pk_bf16(v0[2], v0[3]); w.z = cvt_pk_bf16(v1[0], v1[1]); w.w = cvt_pk_bf16(v1[2], v1[3]);
                    *(u32x4*)(rowp + bj * HALF) = to_store_layout(w, lane); } }
    }
};
template <int ACT  > struct EpiBiasF32 {
    static constexpr bool PERM = false, PREP = false;
    float* out; const float* bias;
    __device__ __forceinline__ void operator()(const Acc& acc, const Unit& u, int wr, int wc, int fr, int fq) const {
        const int lane = fq * 16 + fr, sr = lane >> 2, sq = lane & 3;
        const int row0 = u.pm * BM + wr * 64 + sr, col0 = u.pn * BM + wc * 32 + 4 * fq, cols = u.pn * BM + wc * 32 + 4 * sq;
#pragma unroll
        for (int bj = 0; bj < 2; ++bj)
#pragma unroll
            for (int n = 0; n < 2; ++n) { const f32x4 bv = bias ? *(const f32x4*)(bias + col0 + bj * HALF + n * 16) : (f32x4){0.f, 0.f, 0.f, 0.f};
#pragma unroll
                for (int ai = 0; ai < 2; ++ai)
#pragma unroll
                    for (int m = 0; m < 4; ++m) { f32x4 v = acc[ai][bj][m][n] + bv;
                        if (ACT != 0) {
#pragma unroll
                            for (int j = 0; j < 4; ++j) { const float sg = frcp(1.f + __expf(-v[j])); v[j] = (ACT == 1) ? __expf(-0.6065306597126334f * sg) : sg; } }
                        *(u32x4*)(out + (size_t)(row0 + ai * HALF + m * 16) * DM + cols + bj * HALF + n * 16) = to_store_layout(__builtin_bit_cast(u32x4, v), lane); }
                asm volatile("" ::: "memory"); }
    }
};

template <class Epi, class Sched, bool ALIGN_EPI = true>
__device__ __forceinline__ void gemm_phase(LAS unsigned char* lds, const int wave_s, const Gemm g, const Sched& S, const Epi& E_) {
    int wid_ = wave_s; asm volatile("" : "+s"(wid_));
    int lane_; asm volatile("v_mbcnt_lo_u32_b32 %0, -1, 0\n\tv_mbcnt_hi_u32_b32 %0, -1, %0" : "=v"(lane_));
    const int wid = wid_, lane = lane_, tid = wid * 64 + lane, wr = wid >> 2, wc = wid & 3, fr = lane & 15, fq = lane >> 4;
    int K_ = g.K; asm volatile("" : "+s"(K_));
    const int K = K_, nt = K / BK;
    unsigned voffA[2], voffB[2];
#pragma unroll
    for (int i = 0; i < 2; ++i) { int R, C; stage_rc(tid * 16 + i * 8192, R, C); const int Rb = Epi::PERM ? ((R & ~31) + perm32(R & 31)) : R;
        voffA[i] = (unsigned)(R * g.lda + C) * 2u; voffB[i] = (unsigned)(Rb * g.ldb + C) * 2u; }
    const size_t kstep = (size_t)(BK * 2);
    const size_t hstepA = (size_t)HALF * g.lda * 2, hstepB = (size_t)HALF * g.ldb * 2;
    const size_t tstepA = 2 * hstepA, tstepB = 2 * hstepB;
    const unsigned ldsw = (unsigned)wid * 1024u;
    const int aoff = lds_byte(wr * 64 + fr, fq * 8), boff = lds_byte(wc * 32 + fr, fq * 8);
#define PG8_SA(b, h) (((b) * 2 + (h)) * HTB)
#define PG8_SB(b, h) ((4 + (b) * 2 + (h)) * HTB)
#define PG8_STAGE(bufoff, gbase, voff) do { _Pragma("unroll") for (int _i = 0; _i < 2; ++_i) \
        __builtin_amdgcn_global_load_lds((const unsigned*)((const char*)(gbase) + (voff)[_i]), (LAS unsigned*)(lds + (bufoff) + ldsw + _i * 8192), 16, 0, 0); } while (0)
#define PG8_LDA(dst, b, h) do { _Pragma("unroll") for (int m = 0; m < 4; ++m) _Pragma("unroll") for (int k = 0; k < 2; ++k) dst[m][k] = *(const LAS bf16x8*)(lds + PG8_SA(b, h) + aoff + m * 2048 + k * 1024); } while (0)
#define PG8_LDB(dst, b, h) do { _Pragma("unroll") for (int n = 0; n < 2; ++n) _Pragma("unroll") for (int k = 0; k < 2; ++k) dst[n][k] = *(const LAS bf16x8*)(lds + PG8_SB(b, h) + boff + n * 2048 + k * 1024); } while (0)
#define PG8_MMA(ai, bj, At, Bt) do { __builtin_amdgcn_s_setprio(1); _Pragma("unroll") for (int m = 0; m < 4; ++m) _Pragma("unroll") for (int n = 0; n < 2; ++n) _Pragma("unroll") for (int k = 0; k < 2; ++k) \
        acc[ai][bj][m][n] = __builtin_amdgcn_mfma_f32_16x16x32_bf16(Bt[n][k], At[m][k], acc[ai][bj][m][n], 0, 0, 0); __builtin_amdgcn_s_setprio(0); } while (0)
#define PG8_WAIT_V(n) asm volatile("s_waitcnt vmcnt(" #n ")" ::: "memory")
#define PG8_WAIT_L(n) asm volatile("s_waitcnt lgkmcnt(" #n ")" ::: "memory")
#define PG8_BAR __builtin_amdgcn_s_barrier()
#define PG8_SCHED __builtin_amdgcn_sched_barrier(0)
    Unit cur, nxt; int ui = 0;
    if (!S.next(0, cur)) return;
    Epi E = E_;
    if constexpr (Epi::PREP) E.prep(lds, cur.pm, tid);
    Acc acc;
#pragma unroll
    for (int a = 0; a < 2; ++a)
#pragma unroll
        for (int b = 0; b < 2; ++b)
#pragma unroll
            for (int m = 0; m < 4; ++m)
#pragma unroll
                for (int n = 0; n < 2; ++n) acc[a][b][m][n] = (f32x4){0.f, 0.f, 0.f, 0.f};
    bf16x8 At[4][2], B0[2][2], B1[2][2];
    const char* cA = (const char*)g.A + S.a_off(cur) + (size_t)cur.pm * tstepA; const char* cB = (const char*)g.Bt + (size_t)cur.pn * tstepB;
    PG8_STAGE(PG8_SB(0, 0), cB, voffB); PG8_STAGE(PG8_SB(0, 1), cB + hstepB, voffB); PG8_STAGE(PG8_SA(0, 0), cA, voffA); PG8_STAGE(PG8_SA(0, 1), cA + hstepA, voffA);
    if (wr == 1) PG8_BAR;
    PG8_WAIT_V(2); PG8_BAR;
    PG8_STAGE(PG8_SB(1, 0), cB + kstep, voffB); PG8_STAGE(PG8_SA(1, 0), cA + kstep, voffA); PG8_STAGE(PG8_SB(1, 1), cB + hstepB + kstep, voffB);
    PG8_WAIT_V(6); PG8_BAR;
    for (;;) {
        const bool has_next = S.next(ui + 1, nxt);
        const char* nA = has_next ? (const char*)g.A + S.a_off(nxt) + (size_t)nxt.pm * tstepA : cA; const char* nB = has_next ? (const char*)g.Bt + (size_t)nxt.pn * tstepB : cB;
        for (int t = 0; t < nt; t += 2) {
            const bool last = (t == nt - 2);
            const char* a1 = cA + (size_t)(t + 1) * kstep;
            const char* a2 = last ? nA : cA + (size_t)(t + 2) * kstep; const char* b2 = last ? nB : cB + (size_t)(t + 2) * kstep;
            const char* a3 = a2 + kstep; const char* b3 = b2 + kstep;
            PG8_LDB(B0, 0, 0); PG8_LDB(B1, 0, 1); PG8_SCHED; PG8_LDA(At, 0, 0); PG8_STAGE(PG8_SA(1, 1), a1 + hstepA, voffA);
            PG8_WAIT_V(8); PG8_WAIT_L(0); PG8_BAR; PG8_MMA(0, 0, At, B0); PG8_MMA(0, 1, At, B1); PG8_BAR; PG8_SCHED;
            PG8_LDA(At, 0, 1); PG8_STAGE(PG8_SB(0, 0), b2, voffB); PG8_STAGE(PG8_SB(0, 1), b2 + hstepB, voffB); PG8_STAGE(PG8_SA(0, 0), a2, voffA);
            PG8_WAIT_V(8); PG8_WAIT_L(0); PG8_BAR; PG8_MMA(1, 0, At, B0); PG8_MMA(1, 1, At, B1); PG8_BAR; PG8_SCHED;
            PG8_LDB(B0, 1, 0); PG8_LDB(B1, 1, 1); PG8_SCHED; PG8_LDA(At, 1, 0); PG8_STAGE(PG8_SA(0, 1), a2 + hstepA, voffA);
            PG8_WAIT_V(8); PG8_WAIT_L(0); PG8_BAR; PG8_MMA(0, 0, At, B0); PG8_MMA(0, 1, At, B1); PG8_BAR; PG8_SCHED;
            PG8_LDA(At, 1, 1); PG8_STAGE(PG8_SB(1, 0), b3, voffB); PG8_STAGE(PG8_SB(1, 1), b3 + hstepB, voffB); PG8_STAGE(PG8_SA(1, 0), a3, voffA);
            PG8_WAIT_V(8); PG8_WAIT_L(0); PG8_BAR; PG8_MMA(1, 0, At, B0); PG8_MMA(1, 1, At, B1); PG8_BAR; PG8_SCHED;
        }
        if constexpr (ALIGN_EPI) { if (wr == 0) PG8_BAR; }
        E(acc, cur, wr, wc, fr, fq);
        if (!has_next) break;
#pragma unroll
        for (int a = 0; a < 2; ++a)
#pragma unroll
            for (int b = 0; b < 2; ++b)
#pragma unroll
                for (int m = 0; m < 4; ++m)
#pragma unroll
                    for (int n = 0; n < 2; ++n) acc[a][b][m][n] = (f32x4){0.f, 0.f, 0.f, 0.f};
        cur = nxt; cA = nA; cB = nB; ++ui;
        if constexpr (ALIGN_EPI) { if (wr == 1) PG8_BAR; }
    }
    PG8_WAIT_V(0);
    if constexpr (!ALIGN_EPI) { if (wr == 0) PG8_BAR; }
    PG8_BAR;
#undef PG8_SA
#undef PG8_SB
#undef PG8_STAGE
#undef PG8_LDA
#undef PG8_LDB
#undef PG8_MMA
#undef PG8_WAIT_V
#undef PG8_WAIT_L
#undef PG8_BAR
#undef PG8_SCHED
}
}

constexpr size_t MiB = 1u << 20;
constexpr size_t WS_CTL = 0, CTL_ZERO_BYTES = 2 * MiB;
constexpr size_t WS_W = 2 * MiB;
constexpr size_t WS_XR = 210 * MiB;
constexpr size_t WS_H = 146 * MiB;
constexpr size_t WS_BIG = 274 * MiB;
constexpr size_t WS_END = WS_BIG + 866 * MiB;
constexpr size_t W_QKV = 0, W_AO = 72 * MiB;
constexpr size_t W_SIN = 0, W_SOUT = 8 * MiB, W_SY = 24 * MiB, W_SF = 50 * MiB;
constexpr size_t W_RF = 0, W_R2W = 54 * MiB, W_R2A = 55 * MiB, W_R2G = 56 * MiB, W_RO = 57 * MiB;
constexpr size_t W_M1 = 80 * MiB, W_M2 = 112 * MiB;
constexpr size_t B_QKV = 0, B_LSE = 576 * MiB, B_OG = 580 * MiB;
constexpr size_t B_U = 0, B_XO = 128 * MiB;
constexpr size_t B_RKV = 0, B_LORA = 192 * MiB, B_DEC = 216 * MiB, B_AV = 344 * MiB, B_G = 472 * MiB, B_Y = 216 * MiB, B_X6 = 216 * MiB, B_FR = 536 * MiB;
constexpr size_t B_HID = 0;
constexpr size_t CTL_SSQ = 512 * 1024;
constexpr int CW_BAR = 4096;

constexpr int RING_BYTES = 139264;
constexpr int MISC_OFF = RING_BYTES;
constexpr int LDS_BYTES = RING_BYTES + 256;

#define LDS_WAIT() asm volatile("s_waitcnt lgkmcnt(0)" ::: "memory")
#define VM_WAIT() asm volatile("s_waitcnt vmcnt(0)" ::: "memory")
typedef __bf16 bf16x2_t __attribute__((ext_vector_type(2)));
__device__ __forceinline__ unsigned pk2(float lo, float hi) { const f32x2 v = (f32x2){lo, hi}; const bf16x2_t b = __builtin_convertvector(v, bf16x2_t); return __builtin_bit_cast(unsigned, b); }
__device__ __forceinline__ unsigned f2bf(float f) { return pk2(f, 0.f) & 0xffffu; }
__device__ __forceinline__ float bf_lo(unsigned w) { return __builtin_bit_cast(float, w << 16); }
__device__ __forceinline__ float bf_hi(unsigned w) { return __builtin_bit_cast(float, w & 0xffff0000u); }

#define XB_TMO      128
#define XB_XCNT(j)  (256  + 64 * (j))
#define XB_XSUB(j)  (1280 + 64 * (j))
#define XB_XGEN(j)  (2304 + 64 * (j))
#define XB_TOP      3328
#define XB_TOPGEN   3392
#define XCD_BAR_WORDS 3456
#define XB_SPIN_CAP (1u << 22)
__device__ __forceinline__ unsigned xb_ld(unsigned* p)              { return __hip_atomic_load(p, __ATOMIC_RELAXED, __HIP_MEMORY_SCOPE_AGENT); }
__device__ __forceinline__ unsigned xb_add(unsigned* p, unsigned v) { return __hip_atomic_fetch_add(p, v, __ATOMIC_RELAXED, __HIP_MEMORY_SCOPE_AGENT); }
__device__ __forceinline__ unsigned xb_xcc_id() { return (unsigned)__builtin_amdgcn_s_getreg((3 << 11) | 20) & 0xFu; }
#define XB_SPIN(cond, bar) do { unsigned _sp = 0; while (cond) { __builtin_amdgcn_s_sleep(1); \
    if ((++_sp & 255u) == 0u) { if (xb_ld(&(bar)[XB_TMO])) break; if (_sp > XB_SPIN_CAP) { atomicAdd(&(bar)[XB_TMO], 1u); break; } } } } while (0)
struct XcdBarrier { unsigned* bar; unsigned x; volatile LAS unsigned* st; int wave; };
__device__ __forceinline__ bool xb_leader(int wave) { return wave == 0 && __builtin_amdgcn_mbcnt_hi(~0u, __builtin_amdgcn_mbcnt_lo(~0u, 0u)) == 0u; }
__device__ __forceinline__ XcdBarrier xcd_barrier_post(unsigned* bar, volatile LAS unsigned* st, int wave) {
    XcdBarrier b; b.bar = bar; b.x = xb_xcc_id(); b.st = st; b.wave = wave;
    if (xb_leader(wave)) (void)xb_add(&bar[XB_XCNT(b.x)], 1u);
    return b;
}
__device__ __forceinline__ void xcd_barrier_complete(unsigned* bar, unsigned x, unsigned& nloc, unsigned& nx) {
    const unsigned G = gridDim.x * gridDim.y * gridDim.z;
    unsigned sum, cnt, mine, sp = 0u;
    for (;;) {
        sum = 0u; cnt = 0u; mine = 0u;
#pragma unroll
        for (unsigned j = 0; j < 16; ++j) { const unsigned c = xb_ld(&bar[XB_XCNT(j)]); sum += c; cnt += (c > 0u) ? 1u : 0u; mine = (j == x) ? c : mine; }
        if (sum == G) break;
        __builtin_amdgcn_s_sleep(1);
        if ((++sp & 255u) == 0u) { if (xb_ld(&bar[XB_TMO])) break; if (sp > XB_SPIN_CAP) { atomicAdd(&bar[XB_TMO], 1u); break; } }
    }
    nloc = mine > 0u ? mine : 1u; nx = cnt > 0u ? cnt : 1u;
}
__device__ __forceinline__ void xcd_barrier(const XcdBarrier& b) {
    asm volatile("s_waitcnt vmcnt(0)" ::: "memory");
    __syncthreads();
    if (xb_leader(b.wave)) {
        unsigned* bar = b.bar;
        __builtin_amdgcn_s_waitcnt(0);
        unsigned nloc = b.st[0], nx = b.st[1];
        if (nloc == 0u) { xcd_barrier_complete(bar, b.x, nloc, nx); b.st[0] = nloc; b.st[1] = nx; }
        const unsigned old = xb_add(&bar[XB_XSUB(b.x)], 1u);
        const unsigned gen = old / nloc;
        if (old + 1u == (gen + 1u) * nloc) {
            __builtin_amdgcn_fence(__ATOMIC_RELEASE, "agent");
            asm volatile("s_waitcnt vmcnt(0)" ::: "memory");
            const unsigned og = xb_add(&bar[XB_TOP], 1u);
            const unsigned tg = og / nx;
            if (og + 1u == (tg + 1u) * nx) xb_add(&bar[XB_TOPGEN], 1u);
            else XB_SPIN(xb_ld(&bar[XB_TOPGEN]) == tg, bar);
            __builtin_amdgcn_fence(__ATOMIC_ACQUIRE, "agent");
            xb_add(&bar[XB_XGEN(b.x)], 1u);
            asm volatile("s_waitcnt vmcnt(0)" ::: "memory");
        } else {
            XB_SPIN(xb_ld(&bar[XB_XGEN(b.x)]) == gen, bar);
            __builtin_amdgcn_fence(__ATOMIC_ACQUIRE, "agent");
            asm volatile("s_waitcnt vmcnt(0)" ::: "memory");
        }
    }
    __syncthreads();
}

struct Frame {
    LAS unsigned char* lds;
    int tid, lane, wave, G, gw, NGW;
};
__device__ __forceinline__ Frame phase_frame(const Frame& F0) {
    Frame F = F0; int wv = F0.wave; asm volatile("" : "+s"(wv)); F.wave = wv; int ln; asm volatile("v_mbcnt_lo_u32_b32 %0, -1, 0\n\tv_mbcnt_hi_u32_b32 %0, -1, %0" : "=v"(ln)); F.lane = ln; F.tid = wv * 64 + F.lane;
    F.gw = blockIdx.x * NWAVES + F.wave; return F;
}
template <class T> __device__ __forceinline__ T ldnt(const T* p) { return __builtin_nontemporal_load(p); }
__device__ __forceinline__ float wave_sum(float v) {
#pragma unroll
    for (int o = 1; o < 64; o <<= 1) v += __shfl_xor(v, o);
    return v;
}

__device__ __forceinline__ void cvt_mat(const Frame& F0, const float* src, int ld_src, int Ksrc, int Nsrc, int Kpad, int Npad,
                                        bf16* dst, int ld_dst, int drow0, int dcol0, const float* scale, int smode, int glu) {
    const Frame F = phase_frame(F0);
    LAS float* scr = (LAS float*)(F.lds + F.wave * 8704);
    const int nblk = Npad / 32, nitems = (Kpad / 64) * nblk, lane = F.lane;
    for (int it = F.gw; it < nitems; it += F.NGW) {
        const int kb = it / nblk, nb = it - kb * nblk, k0 = 64 * kb, n0 = 32 * nb;
        float vals[32];
        const int n = n0 + (lane & 31);
        if (k0 + 64 <= Ksrc && n0 + 32 <= Nsrc) {
            const float* sp = src + (size_t)(k0 + (lane >> 5)) * ld_src + n;
#pragma unroll
            for (int i = 0; i < 32; ++i) vals[i] = ldnt(sp + (size_t)(2 * i) * ld_src);
            if (smode) {
#pragma unroll
                for (int i = 0; i < 32; ++i) { const float s = scale[k0 + 2 * i + (lane >> 5)]; vals[i] *= (smode == 1) ? s : (1.f - s); } }
        } else {
#pragma unroll
            for (int i = 0; i < 32; ++i) { const int k = k0 + 2 * i + (lane >> 5); float v = 0.f;
                if (k < Ksrc && n < Nsrc) { v = src[(size_t)k * ld_src + n]; if (smode == 1) v *= scale[k]; else if (smode == 2) v *= (1.f - scale[k]); }
                vals[i] = v; }
        }
#pragma unroll
        for (int i = 0; i < 32; ++i) scr[(2 * i + (lane >> 5)) * 33 + (lane & 31)] = vals[i];
        LDS_WAIT(); asm volatile("" ::: "memory");
        const int c = lane & 7;
#pragma unroll
        for (int j = 0; j < 4; ++j) { const int n = (lane >> 3) + 8 * j; const LAS float* s = scr + (8 * c) * 33 + n;
            u32x4 o; o.x = pk2(s[0 * 33], s[1 * 33]); o.y = pk2(s[2 * 33], s[3 * 33]); o.z = pk2(s[4 * 33], s[5 * 33]); o.w = pk2(s[6 * 33], s[7 * 33]);
            const int nn = n0 + n; int drow;
            if (glu) drow = (nn < 2048) ? (256 * (nn >> 7) + (nn & 127)) : (256 * ((nn - 2048) >> 7) + 128 + ((nn - 2048) & 127)); else drow = drow0 + nn;
            *(u32x4*)(dst + (size_t)drow * ld_dst + dcol0 + k0 + 8 * c) = o; }
        LDS_WAIT(); asm volatile("" ::: "memory");
    }
}

__device__ __forceinline__ void load_row(const void* x, bool is_bf16, int m, int lane, f32x4 (&v)[8]) {
    if (!is_bf16) { const f32x4* xr = (const f32x4*)((const float*)x + (size_t)m * DM) + lane;
#pragma unroll
        for (int j = 0; j < 8; ++j) v[j] = xr[64 * j]; }
    else { const u32x2* xr = (const u32x2*)((const bf16*)x + (size_t)m * DM) + lane;
#pragma unroll
        for (int j = 0; j < 8; ++j) { const u32x2 w = xr[64 * j]; v[j] = (f32x4){bf_lo(w.x), bf_hi(w.x), bf_lo(w.y), bf_hi(w.y)}; } }
}
__device__ __forceinline__ void norm_rows_rwkv(const Frame& F0, const bf16* x, const float* gain, const float* mu, bf16* X6) {
    const Frame F = phase_frame(F0);
    for (int r0 = F.gw * 8; r0 < M; r0 += F.NGW * 8) {
        f32x4 hp[8], v[8];
        const f32x4* gr = (const f32x4*)gain + F.lane;
        if ((r0 & (SEQ - 1)) == 0) {
#pragma unroll
            for (int j = 0; j < 8; ++j) hp[j] = (f32x4){0.f, 0.f, 0.f, 0.f};
        } else { float s = 0.f; load_row(x, true, r0 - 1, F.lane, hp);
#pragma unroll
            for (int j = 0; j < 8; ++j) s += (hp[j].x * hp[j].x + hp[j].y * hp[j].y) + (hp[j].z * hp[j].z + hp[j].w * hp[j].w);
            const float rstd = 1.f / sqrtf(wave_sum(s) * (1.f / DM) + NORM_EPS);
#pragma unroll
            for (int j = 0; j < 8; ++j) hp[j] = hp[j] * rstd * gr[64 * j]; }
        for (int rr = 0; rr < 8; ++rr) { const int m = r0 + rr;
            float s = 0.f; load_row(x, true, m, F.lane, v);
#pragma unroll
            for (int j = 0; j < 8; ++j) s += (v[j].x * v[j].x + v[j].y * v[j].y) + (v[j].z * v[j].z + v[j].w * v[j].w);
            const float rstd = 1.f / sqrtf(wave_sum(s) * (1.f / DM) + NORM_EPS);
#pragma unroll
            for (int j = 0; j < 8; ++j) v[j] = v[j] * rstd * gr[64 * j];
            for (int q = 0; q < 6; ++q) { const f32x4* mr = (const f32x4*)(mu + (size_t)q * DM) + F.lane; u32x2* o = (u32x2*)(X6 + ((size_t)q * M + m) * DM) + F.lane;
#pragma unroll
                for (int j = 0; j < 8; ++j) { const f32x4 mm = mr[64 * j]; const f32x4 xm = v[j] + (hp[j] - v[j]) * mm; u32x2 w; w.x = pk2(xm.x, xm.y); w.y = pk2(xm.z, xm.w); o[64 * j] = w; } }
#pragma unroll
            for (int j = 0; j < 8; ++j) hp[j] = v[j]; }
    }
}
__device__ __forceinline__ void norm_rows(const Frame& F0, const void* x, bool x_bf16, const float* gain, bf16* H, float* outf, int mode) {
    const Frame F = phase_frame(F0);
    for (int m = F.gw; m < M; m += F.NGW) {
        f32x4 v[8]; float s = 0.f; load_row(x, x_bf16, m, F.lane, v);
#pragma unroll
        for (int j = 0; j < 8; ++j) s += (v[j].x * v[j].x + v[j].y * v[j].y) + (v[j].z * v[j].z + v[j].w * v[j].w);
        const float rstd = 1.f / sqrtf(wave_sum(s) * (1.f / DM) + NORM_EPS);
        const f32x4* gr = (const f32x4*)gain + F.lane;
#pragma unroll
        for (int j = 0; j < 8; ++j) { const f32x4 g = gr[64 * j]; v[j] = v[j] * rstd * g; }
        if (mode == 2) { f32x4* o = (f32x4*)(outf + (size_t)m * DM) + F.lane;
#pragma unroll
            for (int j = 0; j < 8; ++j) o[64 * j] = v[j]; }
        else if (mode == 0) { u32x2* o = (u32x2*)(H + (size_t)m * DM) + F.lane;
#pragma unroll
            for (int j = 0; j < 8; ++j) { u32x2 w; w.x = pk2(v[j].x, v[j].y); w.y = pk2(v[j].z, v[j].w); o[64 * j] = w; } }
        else { }
    }
}

typedef short v4i16_t __attribute__((ext_vector_type(4)));
__device__ __forceinline__ unsigned off_b(unsigned row, unsigned ch) { return 256u * row + 16u * (ch ^ (((row & 3u) << 2) | ((row >> 2) & 3u))); }
constexpr int ATT_K_OFF = 0, ATT_V_OFF = 65536;
struct AttnUnit { int g, dsh, blk, hd, fresh; size_t rowbase; };
__device__ __forceinline__ AttnUnit attn_decode(int L, int i) {
    AttnUnit a; int chain;
    if (i < 8) { a.g = 0; chain = L >> 3; a.blk = 8 * (L & 7) + i; a.fresh = (i == 0); }
    else if (i < 16) { a.g = 1; chain = L >> 1; a.blk = 8 * (L & 1) + (i - 8); a.fresh = (i == 8); }
    else { a.g = 2; chain = 2 * L + ((i - 16) >> 2); a.blk = (i - 16) & 3; a.fresh = (a.blk == 0); }
    a.dsh = 2 * a.g; a.hd = chain & 15; const int r = (chain >> 4) & ((1 << a.dsh) - 1), b = chain >> (4 + a.dsh);
    a.rowbase = (size_t)b * SEQ + r; return a;
}
__device__ __forceinline__ void attn_phase(const Frame& F0, const bf16* QKV, float* LSE, bf16* OG) {
    const Frame F = phase_frame(F0);
    LAS unsigned char* lds = F.lds;
    const int tid = F.tid, lane = F.lane, w = F.wave, q16 = lane & 15, grp = lane >> 4, qq = (lane & 15) >> 2, pp = lane & 3;
    u32x4 pk[2][4], pv[2][4]; bf16x8 pq[2][4];
    auto fetch_kv = [&](const AttnUnit& a, const int h) {
        const bf16* Kg = QKV + a.g * 6144 + a.hd * 128 + 2048; const bf16* Vg = Kg + 2048;
#pragma unroll
        for (int i = 0; i < 4; ++i) { const int row = (tid >> 4) + 32 * i, ch = tid & 15;
            const size_t mrow = a.rowbase + ((size_t)(128 * a.blk + row) << a.dsh); pk[h][i] = ldnt((const u32x4*)(Kg + mrow * NQKV + ch * 8)); pv[h][i] = ldnt((const u32x4*)(Vg + mrow * NQKV + ch * 8)); }
    };
    auto fetch_q = [&](const AttnUnit& a, const int h) {
        const bf16* Qg = QKV + a.g * 6144 + a.hd * 128;
        const size_t mq = a.rowbase + ((size_t)(128 * a.blk + 16 * w + q16) << a.dsh);
#pragma unroll
        for (int s = 0; s < 4; ++s) pq[h][s] = ldnt((const bf16x8*)(Qg + mq * NQKV + 32 * s + 8 * grp));
    };
    int par = 0;
    for (int L = blockIdx.x; L < 256; L += gridDim.x) {
        fetch_kv(attn_decode(L, 0), 0); fetch_q(attn_decode(L, 0), 0); fetch_kv(attn_decode(L, 1), 1); fetch_q(attn_decode(L, 1), 1);
        for (int u2 = 0; u2 < 24; u2 += 2) {
#pragma unroll
          for (int h = 0; h < 2; ++h) { const int ui = u2 + h;
            const AttnUnit a = attn_decode(L, ui); const int g = a.g, dsh = a.dsh, d = 1 << dsh, blk = a.blk, hd = a.hd;
            bf16* Og = OG + (size_t)g * M * DM + hd * 128;
#pragma unroll
            for (int i = 0; i < 4; ++i) { const int row = (tid >> 4) + 32 * i, ch = tid & 15;
                *(LAS u32x4*)(lds + ATT_K_OFF + 32768 * par + off_b(row, ch)) = pk[h][i]; *(LAS u32x4*)(lds + ATT_V_OFF + 32768 * par + off_b(row, ch)) = pv[h][i];
                if (a.fresh) {
                    u32x4 k2 = (u32x4){0u, 0u, 0u, 0u}, v2 = k2;
                    if (blk > 0) { const bf16* Kg = QKV + g * 6144 + hd * 128 + 2048; const size_t mrow2 = a.rowbase + ((size_t)(128 * (blk - 1) + row) << dsh); k2 = ldnt((const u32x4*)(Kg + mrow2 * NQKV + ch * 8)); v2 = ldnt((const u32x4*)(Kg + 2048 + mrow2 * NQKV + ch * 8)); }
                    *(LAS u32x4*)(lds + ATT_K_OFF + 32768 * (par ^ 1) + off_b(row, ch)) = k2; *(LAS u32x4*)(lds + ATT_V_OFF + 32768 * (par ^ 1) + off_b(row, ch)) = v2; } }
            const unsigned mq = (unsigned)a.rowbase + ((unsigned)(128 * blk + 16 * w + q16) << dsh);
            __syncthreads();
            if (ui + 2 < 24) fetch_kv(attn_decode(L, ui + 2), h);
            int lq_ = lane; asm volatile("" : "+v"(lq_));
            const int q16_ = lq_ & 15, grp_ = lq_ >> 4, qq_ = (lq_ & 15) >> 2, pp_ = lq_ & 3;
            const unsigned kswz = ((q16_ & 3) << 2) | ((q16_ >> 2) & 3), vswz = (qq_ << 2) | grp_;
            unsigned kaddr[4];
#pragma unroll
            for (int s = 0; s < 4; ++s) kaddr[s] = ATT_K_OFF + 256u * q16_ + 16u * ((4 * s + grp_) ^ kswz);
            f32x4 sacc[9];
#pragma unroll
            for (int T = 0; T < 9; ++T) { sacc[T] = (f32x4){0.f, 0.f, 0.f, 0.f}; const int Tw = w + T; const unsigned toff = 4096u * (Tw & 7) + 32768u * ((Tw >> 3) ? par : (par ^ 1));
#pragma unroll
                for (int s = 0; s < 4; ++s) { const bf16x8 kf = *(const LAS bf16x8*)(lds + kaddr[s] + toff);
                    sacc[T] = __builtin_amdgcn_mfma_f32_16x16x32_bf16(kf, pq[h][s], sacc[T], 0, 0, 0); } }
            asm volatile("" ::: "memory");
            if (ui + 2 < 24) fetch_q(attn_decode(L, ui + 2), h);
            const float slope = exp2f(-8.f * (float)(g * 16 + hd + 1) / 48.f);
            const float c1 = 0.08838834764831845f * 1.4426950408889634f, c2 = slope * (float)d * 1.4426950408889634f;
            const float NEG = -__builtin_inff();
            float mx = NEG;
#pragma unroll
            for (int T = 0; T < 9; ++T)
#pragma unroll
                for (int i = 0; i < 4; ++i) { const int wj = 16 * (w + T) + 4 * grp + i, dist = 128 + 16 * w + q16 - wj;
                    const bool valid = (dist >= 0) && (dist <= 128) && (blk > 0 || wj >= 128);
                    const float s2 = valid ? (sacc[T][i] * c1 - c2 * (float)dist) : NEG; sacc[T][i] = s2; mx = fmaxf(mx, s2); }
            mx = fmaxf(mx, __shfl_xor(mx, 16)); mx = fmaxf(mx, __shfl_xor(mx, 32));
            float lsum = 0.f;
#pragma unroll
            for (int T = 0; T < 9; ++T)
#pragma unroll
                for (int i = 0; i < 4; ++i) { const float p = __builtin_amdgcn_exp2f(sacc[T][i] - mx); sacc[T][i] = p; lsum += p; }
            lsum += __shfl_xor(lsum, 16); lsum += __shfl_xor(lsum, 32);
            bf16x8 pf[5];
#pragma unroll
            for (int ks = 0; ks < 5; ++ks) { u32x4 pw;
                pw.x = pg8::cvt_pk_bf16(sacc[2 * ks][0], sacc[2 * ks][1]); pw.y = pg8::cvt_pk_bf16(sacc[2 * ks][2], sacc[2 * ks][3]);
                if (ks < 4) { pw.z = pg8::cvt_pk_bf16(sacc[2 * ks + 1][0], sacc[2 * ks + 1][1]); pw.w = pg8::cvt_pk_bf16(sacc[2 * ks + 1][2], sacc[2 * ks + 1][3]); } else { pw.z = 0u; pw.w = 0u; }
                pf[ks] = __builtin_bit_cast(bf16x8, pw); }
            const float inv = 1.f / lsum;
            unsigned vaddr[8];
#pragma unroll
            for (int c = 0; c < 8; ++c) vaddr[c] = ATT_V_OFF + 256u * (4 * grp_ + qq_) + 16u * ((2 * c + (pp_ >> 1)) ^ vswz) + 8u * (pp_ & 1);
            unsigned voff[10];
#pragma unroll
            for (int j = 0; j < 10; ++j) { const int Tw = w + j; voff[j] = 4096u * (Tw & 7) + 32768u * (((Tw >> 3) & 1) ? par : (par ^ 1)); if (Tw >= 16) voff[j] = 32768u * par; }
#pragma unroll
            for (int c = 0; c < 8; ++c) { f32x4 o = (f32x4){0.f, 0.f, 0.f, 0.f};
#pragma unroll
                for (int ks = 0; ks < 5; ++ks) {
                    const s16x4 v0 = __builtin_bit_cast(s16x4, __builtin_amdgcn_ds_read_tr16_b64_v4i16((LAS v4i16_t*)(lds + vaddr[c] + voff[2 * ks])));
                    const s16x4 v1 = (ks == 4) ? (s16x4){0, 0, 0, 0}
                                               : __builtin_bit_cast(s16x4, __builtin_amdgcn_ds_read_tr16_b64_v4i16((LAS v4i16_t*)(lds + vaddr[c] + voff[2 * ks + 1])));
                    bf16x8 vf; vf[0] = v0[0]; vf[1] = v0[1]; vf[2] = v0[2]; vf[3] = v0[3]; vf[4] = v1[0]; vf[5] = v1[1]; vf[6] = v1[2]; vf[7] = v1[3];
                    o = __builtin_amdgcn_mfma_f32_16x16x32_bf16(vf, pf[ks], o, 0, 0, 0); }
                u32x2 ow; ow.x = pg8::cvt_pk_bf16(o[0] * inv, o[1] * inv); ow.y = pg8::cvt_pk_bf16(o[2] * inv, o[3] * inv);
                *(u32x2*)(Og + (mq * (unsigned)DM + 16u * c + 4u * grp)) = ow; }
            if (grp == 0) (LSE + (size_t)g * M * 16 + hd)[mq * 16u] = (mx + log2f(lsum)) * 0.6931471805599453f;
            __syncthreads();
            par ^= 1;
          }
        }
    }
}
__device__ __forceinline__ void attn_merge_phase(const Frame& F0, const bf16* OG, const float* LSE, bf16* O) {
    const Frame F = phase_frame(F0);
    const int gt = blockIdx.x * 512 + F.tid, NT = F.G * 512;
    for (int idx = gt; idx < M * 256; idx += NT) {
        const int m = idx >> 8, ch = idx & 255, hd = ch >> 4;
        const float l0 = LSE[((size_t)0 * M + m) * 16 + hd], l1 = LSE[((size_t)1 * M + m) * 16 + hd], l2 = LSE[((size_t)2 * M + m) * 16 + hd];
        const float mx = fmaxf(l0, fmaxf(l1, l2)); float w0 = __expf(l0 - mx), w1 = __expf(l1 - mx), w2 = __expf(l2 - mx); const float inv = frcp(w0 + w1 + w2); w0 *= inv; w1 *= inv; w2 *= inv;
        const bf16* base = OG + (size_t)m * DM + ch * 8;
        const u32x4 a = ldnt((const u32x4*)(base)), b = ldnt((const u32x4*)(base + (size_t)M * DM)), c = ldnt((const u32x4*)(base + 2 * (size_t)M * DM));
        u32x4 o;
#pragma unroll
        for (int j = 0; j < 4; ++j) { const float lo = w0 * bf_lo(a[j]) + w1 * bf_lo(b[j]) + w2 * bf_lo(c[j]), hi = w0 * bf_hi(a[j]) + w1 * bf_hi(b[j]) + w2 * bf_hi(c[j]); o[j] = pk2(lo, hi); }
        *(u32x4*)(O + (size_t)m * DM + ch * 8) = o;
    }
}

__device__ __forceinline__ void s5_zoh(float ldt, float are, float aim, float& abr, float& abi, float& cr, float& ci) {
    const float dt = expf(ldt), mag = expf(dt * are); float sn, cs; sincosf(dt * aim, &sn, &cs);
    abr = mag * cs; abi = mag * sn; const float den = are * are + aim * aim, zr = abr - 1.f;
    cr = (zr * are + abi * aim) / den; ci = (abi * are - zr * aim) / den;
}
__device__ __forceinline__ void s5_precompute(const Frame& F0, const float* log_dt, const float* a_re, const float* a_im, const float* b_re, const float* b_im,
                                              const float* c_re, const float* c_im, const float* dsk, bf16* Wy, bf16* Wf) {
    const Frame F = phase_frame(F0); const int tid = F.tid;
    LAS float* pwr = (LAS float*)F.lds; LAS float* pwi = pwr + 17 * 64; LAS float* bbr = pwi + 17 * 64; LAS float* bbi = bbr + 1024; LAS float* cr_ = bbi + 1024; LAS float* ci_ = cr_ + 1024;
    LAS float* Kl = ci_ + 1024; LAS float* dl = Kl + 4096;
    for (int gi = blockIdx.x; gi < 256; gi += gridDim.x) { const int g = gi & 127, hf = gi >> 7;
        __syncthreads();
        if (tid < 64) { const int p = tid; float abr, abi, cr, ci; s5_zoh(log_dt[g], a_re[g * 64 + p], a_im[g * 64 + p], abr, abi, cr, ci);
            float pr = 1.f, pi = 0.f;
            for (int j = 0; j <= 16; ++j) { pwr[j * 64 + p] = pr; pwi[j * 64 + p] = pi; const float nr = pr * abr - pi * abi, ni = pr * abi + pi * abr; pr = nr; pi = ni; }
            for (int c = 0; c < 16; ++c) { const float br = b_re[(size_t)(g * 64 + p) * 16 + c], bi = b_im[(size_t)(g * 64 + p) * 16 + c]; bbr[p * 16 + c] = cr * br - ci * bi; bbi[p * 16 + c] = cr * bi + ci * br; } }
        for (int i = tid; i < 1024; i += 512) { cr_[i] = c_re[(size_t)g * 1024 + i]; ci_[i] = c_im[(size_t)g * 1024 + i]; }
        if (tid < 16) dl[tid] = dsk[g * 16 + tid];
        __syncthreads();
        for (int i2 = tid; i2 < 2048; i2 += 512) { const int j = i2 >> 7, c = 8 * hf + ((i2 >> 4) & 7), c2 = i2 & 15, idx = (j * 16 + c) * 16 + c2; float s = 0.f;
            for (int p = 0; p < 64; ++p) { const float car = cr_[c * 64 + p] * pwr[j * 64 + p] - ci_[c * 64 + p] * pwi[j * 64 + p], cai = cr_[c * 64 + p] * pwi[j * 64 + p] + ci_[c * 64 + p] * pwr[j * 64 + p];
                s += car * bbr[p * 16 + c2] - cai * bbi[p * 16 + c2]; }
            Kl[idx] = s; }
        __syncthreads();
        for (int i2 = tid; i2 < 128 * 48; i2 += 512) { const int r2 = i2 / 48, ch = i2 - r2 * 48, t = r2 >> 3, c = 8 * hf + (r2 & 7), row = t * 16 + c; float v[8];
            if (ch < 32) { const int s = ch >> 1, c2b = (ch & 1) * 8;
#pragma unroll
                for (int e = 0; e < 8; ++e) v[e] = (s <= t) ? (Kl[(((t - s) * 16 + c) * 16) + c2b + e] + ((s == t && c2b + e == c) ? dl[c] : 0.f)) : 0.f;
            } else { const int q0 = (ch - 32) * 8;
#pragma unroll
                for (int e = 0; e < 8; ++e) { const int q = q0 + e, p = q & 63; const float a = cr_[c * 64 + p], bq = ci_[c * 64 + p], wr_ = pwr[(t + 1) * 64 + p], wi_ = pwi[(t + 1) * 64 + p];
                    v[e] = (q < 64) ? (a * wr_ - bq * wi_) : -(a * wi_ + bq * wr_); } }
            u32x4 o; o.x = pk2(v[0], v[1]); o.y = pk2(v[2], v[3]); o.z = pk2(v[4], v[5]); o.w = pk2(v[6], v[7]);
            *(u32x4*)(Wy + ((size_t)g * 256 + row) * 384 + 8 * ch) = o; }
        for (int i2 = tid; i2 < 128 * 32; i2 += 512) { const int row = 128 * hf + (i2 >> 5), ch = i2 & 31, s = ch >> 1, c2b = (ch & 1) * 8, p = row & 63; float v[8];
#pragma unroll
            for (int e = 0; e < 8; ++e) { const float wr_ = pwr[(15 - s) * 64 + p], wi_ = pwi[(15 - s) * 64 + p], br = bbr[p * 16 + c2b + e], bi = bbi[p * 16 + c2b + e];
                v[e] = (row < 64) ? (wr_ * br - wi_ * bi) : ((row < 128) ? (wr_ * bi + wi_ * br) : 0.f); }
            u32x4 o; o.x = pk2(v[0], v[1]); o.y = pk2(v[2], v[3]); o.z = pk2(v[4], v[5]); o.w = pk2(v[6], v[7]);
            *(u32x4*)(Wf + ((size_t)g * 256 + row) * 256 + 8 * ch) = o; }
    }
    __syncthreads();
}
__device__ __forceinline__ void s5_chunk_scan(const Frame& F, int pair, const float* Xout, bf16* U16, const float* log_dt, const float* a_re, const float* a_im) {
    const int g = pair & 127, p = F.lane, w = F.wave; float qr, qi, c0_, c1_; s5_zoh(log_dt[g], a_re[g * 64 + p], a_im[g * 64 + p], qr, qi, c0_, c1_);
#pragma unroll
    for (int i = 0; i < 4; ++i) { const float nr = qr * qr - qi * qi, ni = 2.f * qr * qi; qr = nr; qi = ni; }
    float Pr = qr, Pi = qi;
#pragma unroll
    for (int i = 0; i < 6; ++i) { const float nr = Pr * Pr - Pi * Pi, ni = 2.f * Pr * Pi; Pr = nr; Pi = ni; }
    const float* xo = Xout + ((size_t)pair * 512 + 64 * w) * 128 + p; bf16* ur = U16 + ((size_t)pair * 512 + 64 * w) * 512 + 256 + p;
    float er[32], ei[32]; const float* xo2 = xo;
    float lr = 0.f, li = 0.f;
#pragma unroll 1
    for (int hb = 0; hb < 2; ++hb) {
#pragma unroll
        for (int k = 0; k < 32; ++k) { er[k] = xo[0]; ei[k] = xo[64]; xo += 128; asm volatile("" : "+v"(xo)); }
#pragma unroll
        for (int k = 0; k < 32; ++k) { const float nr = qr * lr - qi * li + er[k], ni = qr * li + qi * lr + ei[k]; lr = nr; li = ni; } }
    LAS float* seg = (LAS float*)F.lds;
    seg[(w * 2 + 0) * 64 + p] = lr; seg[(w * 2 + 1) * 64 + p] = li;
    __syncthreads();
    float xr = 0.f, xi = 0.f;
    for (int v = 0; v < w; ++v) { const float sr = seg[(v * 2 + 0) * 64 + p], si = seg[(v * 2 + 1) * 64 + p]; const float nr = Pr * xr - Pi * xi + sr, ni = Pr * xi + Pi * xr + si; xr = nr; xi = ni; }
    xo = xo2;
#pragma unroll 1
    for (int hb = 0; hb < 2; ++hb) {
#pragma unroll
        for (int k = 0; k < 32; ++k) { er[k] = xo[0]; ei[k] = xo[64]; xo += 128; asm volatile("" : "+v"(xo)); }
#pragma unroll
        for (int k = 0; k < 32; ++k) { ur[0] = (bf16)f2bf(xr); ur[64] = (bf16)f2bf(xi); ur += 512; asm volatile("" : "+v"(ur));
            const float nr = qr * xr - qi * xi + er[k], ni = qr * xi + qi * xr + ei[k]; xr = nr; xi = ni; } }
    __syncthreads();
}

__device__ __forceinline__ float sigmoidf_(float z) { return 1.f / (1.f + __expf(-z)); }
__device__ __forceinline__ float rwkv_decay(float z) { return __expf(-0.6065306597126334f / (1.f + __expf(-z))); }
constexpr int RW_TC = 32, RW_BUF = 5 * RW_TC * 64 * 4 + RW_TC * 16 * 4;
constexpr int RW_Y_OFF = 2 * RW_BUF;
__device__ __forceinline__ float row16_sum(float x) {
    x += __builtin_bit_cast(float, __builtin_amdgcn_update_dpp(0, __builtin_bit_cast(int, x), 0x128, 0xf, 0xf, false));
    x += __builtin_bit_cast(float, __builtin_amdgcn_update_dpp(0, __builtin_bit_cast(int, x), 0x124, 0xf, 0xf, false));
    x += __builtin_bit_cast(float, __builtin_amdgcn_update_dpp(0, __builtin_bit_cast(int, x), 0x122, 0xf, 0xf, false));
    x += __builtin_bit_cast(float, __builtin_amdgcn_update_dpp(0, __builtin_bit_cast(int, x), 0x121, 0xf, 0xf, false));
    return x;
}
__device__ __forceinline__ f32x2 pk_fma(f32x2 a, f32x2 b, f32x2 c) { return __builtin_elementwise_fma(a, b, c); }
#define RW_BAR() do { asm volatile("s_waitcnt lgkmcnt(0)" ::: "memory"); __builtin_amdgcn_s_barrier(); asm volatile("" ::: "memory"); } while (0)
__device__ __forceinline__ void rwkv_scan_phase(const Frame& F0, const bf16* RKV, const float* DEC, const float* AV, float* Y, const float* k_k, const float* k_a) {
    const Frame F = phase_frame(F0);
    const int tid = F.tid, lane = F.lane, w = F.wave;
    const bf16* Rb = RKV; const bf16* Kb = RKV + (size_t)M * DM; const bf16* Vb = RKV + 2 * (size_t)M * DM;
    constexpr int NCH = SEQ / RW_TC;
    for (int unit = blockIdx.x; unit < 256; unit += gridDim.x) {
        const int b = unit >> 7, hh = (unit >> 2) & 31, rq = unit & 3;
        const size_t m0 = (size_t)b * SEQ; const int colh = hh * 64;
        const bool scanner = w < 4;
        const int pt = (tid - 256) >> 3, pc8 = (tid - 256) & 7;
        f32x4 kkc0, kkc1, kac0, kac1;
        if (!scanner) { kkc0 = *(const f32x4*)(k_k + colh + 8 * pc8); kkc1 = *(const f32x4*)(k_k + colh + 8 * pc8 + 4); kac0 = *(const f32x4*)(k_a + colh + 8 * pc8); kac1 = *(const f32x4*)(k_a + colh + 8 * pc8 + 4); }
        const int srow = 4 * w + (lane >> 4), scq = lane & 15;
        f32x2 s01 = (f32x2){0.f, 0.f}, s23 = (f32x2){0.f, 0.f};
        u32x4 pkw, prw; f32x4 pd0, pd1, pa0, pa1; unsigned pvw;
        auto issue = [&](int ch) {
            const size_t m = m0 + (size_t)ch * RW_TC + pt; const int col = colh + 8 * pc8;
            pkw = *(const u32x4*)(Kb + m * DM + col); prw = *(const u32x4*)(Rb + m * DM + col);
            pd0 = *(const f32x4*)(DEC + m * DM + col); pd1 = *(const f32x4*)(DEC + m * DM + col + 4); pa0 = *(const f32x4*)(AV + m * DM + col); pa1 = *(const f32x4*)(AV + m * DM + col + 4);
            pvw = *(const unsigned*)(Vb + m * DM + colh + rq * 16 + 2 * pc8);
        };
        auto process = [&](int bi) {
            LAS float* base = (LAS float*)(F.lds + bi * RW_BUF);
            f32x4 d0 = pd0, d1 = pd1, a0 = pa0, a1 = pa1;
#pragma unroll
            for (int j = 0; j < 4; ++j) { }
            float kf[8], rf[8], kk[8], af[8], kkc[8], kac[8];
#pragma unroll
            for (int j = 0; j < 4; ++j) { kf[2 * j] = bf_lo(pkw[j]); kf[2 * j + 1] = bf_hi(pkw[j]); rf[2 * j] = bf_lo(prw[j]); rf[2 * j + 1] = bf_hi(prw[j]); af[j] = a0[j]; af[4 + j] = a1[j];
                kkc[j] = kkc0[j]; kkc[4 + j] = kkc1[j]; kac[j] = kac0[j]; kac[4 + j] = kac1[j]; }
            float ss = 0.f;
#pragma unroll
            for (int j = 0; j < 8; ++j) { kk[j] = kf[j] * kkc[j]; ss += kk[j] * kk[j]; }
            ss += __shfl_xor(ss, 1); ss += __shfl_xor(ss, 2); ss += __shfl_xor(ss, 4);
            const float rn = 1.f / fmaxf(sqrtf(ss), 1e-12f);
            f32x4 A0, A1, B0, B1, K0, K1, R0, R1;
#pragma unroll
            for (int j = 0; j < 4; ++j) { const float n0 = kk[j] * rn, n1 = kk[4 + j] * rn; A0[j] = -n0; A1[j] = -n1; B0[j] = n0 * af[j]; B1[j] = n1 * af[4 + j];
                K0[j] = kf[j] * (1.f + (af[j] - 1.f) * kac[j]); K1[j] = kf[4 + j] * (1.f + (af[4 + j] - 1.f) * kac[4 + j]); R0[j] = rf[j]; R1[j] = rf[4 + j]; }
            LAS float* o = base + pt * 64 + 8 * pc8;
            *(LAS f32x4*)(o) = d0; *(LAS f32x4*)(o + 4) = d1;
            *(LAS f32x4*)(o + 2048) = A0; *(LAS f32x4*)(o + 2048 + 4) = A1;
            *(LAS f32x4*)(o + 4096) = B0; *(LAS f32x4*)(o + 4096 + 4) = B1;
            *(LAS f32x4*)(o + 6144) = K0; *(LAS f32x4*)(o + 6144 + 4) = K1;
            *(LAS f32x4*)(o + 8192) = R0; *(LAS f32x4*)(o + 8192 + 4) = R1;
            base[10240 + pt * 16 + 2 * pc8] = bf_lo(pvw); base[10240 + pt * 16 + 2 * pc8 + 1] = bf_hi(pvw);
        };
        auto flush_y = [&](int ch, int bi) {
            const LAS float* yb = (const LAS float*)(F.lds + RW_Y_OFF + bi * 2048);
            const size_t m = m0 + (size_t)ch * RW_TC + pt;
            f32x2 yv; yv.x = yb[pt * 16 + 2 * pc8]; yv.y = yb[pt * 16 + 2 * pc8 + 1];
            *(f32x2*)(Y + m * DM + colh + rq * 16 + 2 * pc8) = yv;
        };
        if (!scanner) { issue(0); process(0); issue(1); }
        RW_BAR();
        for (int ch = 0; ch < NCH; ++ch) {
            if (scanner) {
                const LAS float* base = (const LAS float*)(F.lds + (ch & 1) * RW_BUF) + 4 * scq;
                const LAS float* vb = (const LAS float*)(F.lds + (ch & 1) * RW_BUF) + 10240 + srow;
                LAS float* yb = (scq == 0) ? (LAS float*)(F.lds + RW_Y_OFF + (ch & 1) * 2048) + srow : (LAS float*)(F.lds + RW_Y_OFF + 4096) + lane;
                f32x4 wv = *(const LAS f32x4*)(base), av = *(const LAS f32x4*)(base + 2048), bv = *(const LAS f32x4*)(base + 4096), kv = *(const LAS f32x4*)(base + 6144), rv = *(const LAS f32x4*)(base + 8192);
                float vv = vb[0];
                f32x4 wv1 = *(const LAS f32x4*)(base + 64), av1 = *(const LAS f32x4*)(base + 64 + 2048), bv1 = *(const LAS f32x4*)(base + 64 + 4096), kv1 = *(const LAS f32x4*)(base + 64 + 6144), rv1 = *(const LAS f32x4*)(base + 64 + 8192);
                float vv1 = vb[16];
                float ypend = 0.f;
#pragma unroll
                for (int t = 0; t < RW_TC; ++t) {
                    const int tn = (t + 2 < RW_TC) ? t + 2 : RW_TC - 1;
                    const LAS float* o = base + tn * 64;
                    const f32x4 nwv = *(const LAS f32x4*)(o), nav = *(const LAS f32x4*)(o + 2048), nbv = *(const LAS f32x4*)(o + 4096), nkv = *(const LAS f32x4*)(o + 6144), nrv = *(const LAS f32x4*)(o + 8192);
                    const float nvv = vb[tn * 16];
                    f32x2 p = s01 * (f32x2){av[0], av[1]}; p = pk_fma(s23, (f32x2){av[2], av[3]}, p);
                    float sa = p.x + p.y, yr = ypend;
                    sa = row16_sum(sa); yr = row16_sum(yr);
                    if (t > 0) yb[(t - 1) * 16] = yr;
                    const f32x2 sa2 = (f32x2){sa, sa}, vv2 = (f32x2){vv, vv};
                    s01 = pk_fma(s01, (f32x2){wv[0], wv[1]}, pk_fma(sa2, (f32x2){bv[0], bv[1]}, vv2 * (f32x2){kv[0], kv[1]}));
                    s23 = pk_fma(s23, (f32x2){wv[2], wv[3]}, pk_fma(sa2, (f32x2){bv[2], bv[3]}, vv2 * (f32x2){kv[2], kv[3]}));
                    f32x2 q = s01 * (f32x2){rv[0], rv[1]}; q = pk_fma(s23, (f32x2){rv[2], rv[3]}, q);
                    ypend = q.x + q.y;
                    wv = wv1; av = av1; bv = bv1; kv = kv1; rv = rv1; vv = vv1;
                    wv1 = nwv; av1 = nav; bv1 = nbv; kv1 = nkv; rv1 = nrv; vv1 = nvv;
                }
                yb[(RW_TC - 1) * 16] = row16_sum(ypend);
            } else {
                if (ch + 1 < NCH) process((ch + 1) & 1);
                if (ch + 2 < NCH) issue(ch + 2);
                if (ch > 0) flush_y(ch - 1, (ch - 1) & 1);
            }
            RW_BAR();
        }
        if (!scanner) flush_y(NCH - 1, (NCH - 1) & 1);
        RW_BAR();
    }
}

__device__ __forceinline__ unsigned cvtpk_s(float lo, float hi) { const f32x2 v = (f32x2){lo, hi}; const bf16x2_t b = __builtin_convertvector(v, bf16x2_t); return __builtin_bit_cast(unsigned, b); }
constexpr int RF_AT = 0, RF_RT = 2048, RF_BF = 4096, RF_KF = 6144, RF_G4 = 8192, RF_GT = 10240, RF_BON = 10496, RF_BYTES = 10560, RF_NCH = SEQ / 16;
constexpr int RF_PIECES = RF_BYTES / 16, RF_V = RF_BYTES, RF_G = RF_BYTES + 2048, RF_SLOT = RF_BYTES + 4096, RF_YL = 8 * RF_SLOT;
__device__ __forceinline__ bf16x8 frag_lo4(f32x4 c) { u32x4 w; w.x = cvtpk_s(c[0], c[1]); w.y = cvtpk_s(c[2], c[3]); w.z = 0u; w.w = 0u; return __builtin_bit_cast(bf16x8, w); }
__device__ __forceinline__ bf16x8 frag_u2(u32x2 v) { u32x4 w; w.x = v.x; w.y = v.y; w.z = 0u; w.w = 0u; return __builtin_bit_cast(bf16x8, w); }
__device__ __forceinline__ f32x4 mfma16(bf16x8 a, bf16x8 b, f32x4 c) { return __builtin_amdgcn_mfma_f32_16x16x32_bf16(a, b, c, 0, 0, 0); }
__device__ __forceinline__ void st16_wt(void* p, u32x4 v) { asm volatile("global_store_dwordx4 %0, %1, off sc1\n\ts_nop 1" :: "v"(p), "v"(v) : "memory"); }
__device__ __forceinline__ void st8_wt(void* p, u32x2 v) { asm volatile("global_store_dwordx2 %0, %1, off sc1" :: "v"(p), "v"(v) : "memory"); }
__device__ __forceinline__ void st4_wt(void* p, float v) { asm volatile("global_store_dword %0, %1, off sc1" :: "v"(p), "v"(v) : "memory"); }
constexpr int RF_ROUND = 24, RF_NROUND = (RF_NCH + RF_ROUND - 1) / RF_ROUND, CW_RFCNT = 12288;
__device__ __forceinline__ float wave_sum_dpp(float x) {
    x = row16_sum(x);
    x += __builtin_bit_cast(float, __builtin_amdgcn_update_dpp(0, __builtin_bit_cast(int, x), 0x142, 0xa, 0xf, false));
    x += __builtin_bit_cast(float, __builtin_amdgcn_update_dpp(0, __builtin_bit_cast(int, x), 0x143, 0xc, 0xf, false));
    return __builtin_bit_cast(float, __builtin_amdgcn_readlane(__builtin_bit_cast(int, x), 63));
}
__device__ __forceinline__ void rwkv_frames_phase(const Frame& F0, const bf16* RKV, const float* DEC, const bf16* AV, const float* k_k, const float* k_a, const float* r_k, unsigned char* FR, int wv0, int nwv, unsigned* cnt) {
    const Frame F = phase_frame(F0); const int lane = F.lane, r16 = lane & 15, g4 = lane >> 4;
    const bf16* Rb = RKV; const bf16* Kb = RKV + (size_t)M * DM;
    LAS bf16* XA = (LAS bf16*)(F.lds + F.wave * 16384); LAS bf16* XB = XA + 1024; LAS bf16* XK = XA + 2048; LAS bf16* XR_ = XA + 3072;
    LAS float* RW_ = (LAS float*)(XA + 4096); LAS float* RAs = RW_ + 1024;
    const f32x4 Z = (f32x4){0.f, 0.f, 0.f, 0.f};
    u32x4 k0, k1, r0, r1, ab0, ab1; f32x4 w0, w1, w2, w3;
#define RA_LOAD(item_) do { const int it_ = (item_), head_ = it_ & 63, c_ = it_ >> 6; \
        const size_t o = ((size_t)(head_ >> 5) * SEQ + (size_t)c_ * 16 + (lane >> 2)) * DM + (head_ & 31) * 64 + (lane & 3) * 16; \
        k0 = ldnt((const u32x4*)(Kb + o)); k1 = ldnt((const u32x4*)(Kb + o + 8)); r0 = ldnt((const u32x4*)(Rb + o)); r1 = ldnt((const u32x4*)(Rb + o + 8)); \
        w0 = ldnt((const f32x4*)(DEC + o)); w1 = ldnt((const f32x4*)(DEC + o + 4)); w2 = ldnt((const f32x4*)(DEC + o + 8)); w3 = ldnt((const f32x4*)(DEC + o + 12)); \
        ab0 = ldnt((const u32x4*)(AV + o)); ab1 = ldnt((const u32x4*)(AV + o + 8)); } while (0)
    constexpr int RA_TOTAL = BATCH * 32 * RF_NCH;
    int prev_round = -1;
    RA_LOAD(min(F.gw - wv0, RA_TOTAL - 1));
    for (int item = F.gw - wv0; item < RA_TOTAL; item += nwv) {
        const int head = item & 63, c = item >> 6, chunk = head * RF_NCH + c, hh = head & 31, col = hh * 64 + lane;
        unsigned char* fr = FR + (size_t)chunk * RF_BYTES;
        const float kkc = k_k[col], kac = k_a[col], rkc = r_k[col]; float bonv = 0.f;
        { const int lt_ = lane >> 2, lc = (lane & 3) * 16;
          *(LAS u32x4*)(XA + lt_ * 64 + lc) = k0; *(LAS u32x4*)(XA + lt_ * 64 + lc + 8) = k1; *(LAS u32x4*)(XR_ + lt_ * 64 + lc) = r0; *(LAS u32x4*)(XR_ + lt_ * 64 + lc + 8) = r1;
          LAS f32x4* wp = (LAS f32x4*)(RW_ + lt_ * 64 + lc); wp[0] = w0; wp[1] = w1; wp[2] = w2; wp[3] = w3;
          LAS f32x4* ap = (LAS f32x4*)(RAs + lt_ * 64 + lc);
          ap[0] = (f32x4){bf_lo(ab0.x), bf_hi(ab0.x), bf_lo(ab0.y), bf_hi(ab0.y)}; ap[1] = (f32x4){bf_lo(ab0.z), bf_hi(ab0.z), bf_lo(ab0.w), bf_hi(ab0.w)};
          ap[2] = (f32x4){bf_lo(ab1.x), bf_hi(ab1.x), bf_lo(ab1.y), bf_hi(ab1.y)}; ap[3] = (f32x4){bf_lo(ab1.z), bf_hi(ab1.z), bf_lo(ab1.w), bf_hi(ab1.w)}; }
        LDS_WAIT(); asm volatile("" ::: "memory");
        RA_LOAD(min(item + nwv, RA_TOTAL - 1));
        float kf[16], rf[16], wv[16], as_[16];
#pragma unroll
        for (int t = 0; t < 16; ++t) { kf[t] = __builtin_bit_cast(float, (unsigned)XA[t * 64 + lane] << 16); rf[t] = __builtin_bit_cast(float, (unsigned)XR_[t * 64 + lane] << 16); wv[t] = RW_[t * 64 + lane]; as_[t] = RAs[t * 64 + lane]; }
        LDS_WAIT(); asm volatile("" ::: "memory");
        float gc = 1.f, bt[16], kt[16];
#pragma unroll
        for (int t = 0; t < 16; ++t) {
            const float kk = kf[t] * kkc, kkn = kk / fmaxf(sqrtf(wave_sum_dpp(kk * kk)), 1e-12f);
            const float gprev = gc; gc *= wv[t]; const float rg = 1.f / gc;
            const float kp = kf[t] * (1.f + (as_[t] - 1.f) * kac); const float bsum = wave_sum_dpp(rf[t] * kp * rkc); bonv = (lane == t) ? bsum : bonv;
            const float at = -kkn * gprev, rt = rf[t] * gc; bt[t] = kkn * as_[t] * rg; kt[t] = kp * rg;
            const bf16 ab = (bf16)f2bf(at), rb = (bf16)f2bf(rt);
            XA[t * 64 + lane] = ab; XB[t * 64 + lane] = (bf16)f2bf(bt[t]); XK[t * 64 + lane] = (bf16)f2bf(kt[t]); XR_[t * 64 + lane] = rb;
        }
        if (prev_round >= 0) {
            asm volatile("s_waitcnt vmcnt(0)" ::: "memory");
            if (lane == 0) __hip_atomic_fetch_add(cnt + 64 * prev_round, 1u, __ATOMIC_RELAXED, __HIP_MEMORY_SCOPE_AGENT); }
        prev_round = c / RF_ROUND;
#pragma unroll
        for (int q = 0; q < 4; ++q) { u32x2 wb, wk; wb.x = pk2(bt[4 * q], bt[4 * q + 1]); wb.y = pk2(bt[4 * q + 2], bt[4 * q + 3]); wk.x = pk2(kt[4 * q], kt[4 * q + 1]); wk.y = pk2(kt[4 * q + 2], kt[4 * q + 3]);
            const int slot = (lane >> 4) * 64 + (lane & 15) + 16 * q;
            st8_wt((u32x2*)(fr + RF_BF) + slot, wb); st8_wt((u32x2*)(fr + RF_KF) + slot, wk); }
        st4_wt((float*)(fr + RF_GT) + lane, gc); if (lane < 16) st4_wt((float*)(fr + RF_BON) + lane, bonv);
        LDS_WAIT(); asm volatile("" ::: "memory");
#pragma unroll
        for (int i = 0; i < 2; ++i) { const int p = lane + 64 * i, t = p >> 3, ch = p & 7, dstp = t * 8 + (ch ^ (t & 7));
            st16_wt((u32x4*)(fr + RF_AT) + dstp, *(const LAS u32x4*)(XA + p * 8)); st16_wt((u32x4*)(fr + RF_RT) + dstp, *(const LAS u32x4*)(XR_ + p * 8)); }
        bf16x8 fa[2], fb[2], fk[2], frr[2];
#pragma unroll
        for (int ks = 0; ks < 2; ++ks) { const int o = r16 * 64 + 32 * ks + 8 * g4;
            fa[ks] = *(const LAS bf16x8*)(XA + o); fb[ks] = *(const LAS bf16x8*)(XB + o); fk[ks] = *(const LAS bf16x8*)(XK + o); frr[ks] = *(const LAS bf16x8*)(XR_ + o); }
        f32x4 CA = mfma16(fb[1], fa[1], mfma16(fb[0], fa[0], Z)), CAk = mfma16(fk[1], fa[1], mfma16(fk[0], fa[0], Z));
        f32x4 CBab = mfma16(fb[1], frr[1], mfma16(fb[0], frr[0], Z)), CBak = mfma16(fk[1], frr[1], mfma16(fk[0], frr[0], Z));
        f32x4 CAT = mfma16(fa[1], fb[1], mfma16(fa[0], fb[0], Z));
        f32x4 ident;
#pragma unroll
        for (int i = 0; i < 4; ++i) { const int s = 4 * g4 + i; CA[i] = (s < r16) ? CA[i] : 0.f; CAk[i] = (s < r16) ? CAk[i] : 0.f; CBab[i] = (s <= r16) ? CBab[i] : 0.f; CBak[i] = (s <= r16) ? CBak[i] : 0.f;
            CAT[i] = (r16 < s) ? CAT[i] : 0.f; ident[i] = (s == r16) ? 1.f : 0.f; }
        const f32x4 CA2 = mfma16(frag_lo4(CAT), frag_lo4(CA), Z), CA2T = mfma16(frag_lo4(CA), frag_lo4(CAT), Z);
        const f32x4 CA4 = mfma16(frag_lo4(CA2T), frag_lo4(CA2), Z), CA4T = mfma16(frag_lo4(CA2), frag_lo4(CA2T), Z);
        const f32x4 CA8 = mfma16(frag_lo4(CA4T), frag_lo4(CA4), Z);
        f32x4 P = CA8 + ident;
        P = mfma16(frag_lo4(CA4T), frag_lo4(P), P); P = mfma16(frag_lo4(CA2T), frag_lo4(P), P); P = mfma16(frag_lo4(CAT), frag_lo4(P), P);
        u32x2* g4p = (u32x2*)(fr + RF_G4);
        { u32x2 w; w.x = cvtpk_s(CAk[0], CAk[1]); w.y = cvtpk_s(CAk[2], CAk[3]); st8_wt(g4p + lane, w); }
        { u32x2 w; w.x = cvtpk_s(P[0], P[1]); w.y = cvtpk_s(P[2], P[3]); st8_wt(g4p + 64 + lane, w); }
        { u32x2 w; w.x = cvtpk_s(CBab[0], CBab[1]); w.y = cvtpk_s(CBab[2], CBab[3]); st8_wt(g4p + 128 + lane, w); }
        { u32x2 w; w.x = cvtpk_s(CBak[0], CBak[1]); w.y = cvtpk_s(CBak[2], CBak[3]); st8_wt(g4p + 192 + lane, w); }
        LDS_WAIT(); asm volatile("" ::: "memory");
    }
    if (prev_round >= 0) { asm volatile("s_waitcnt vmcnt(0)" ::: "memory");
        if (lane == 0) __hip_atomic_fetch_add(cnt + 64 * prev_round, 1u, __ATOMIC_RELAXED, __HIP_MEMORY_SCOPE_AGENT); }
#undef RA_LOAD
}
__device__ __forceinline__ void rwkv_chunk_scan_phase(const Frame& F0, const unsigned char* FR, const bf16* RKV, const bf16* G, bf16* YG, const float* ln_w, const float* ln_b, int nrb, unsigned* cnt) {
    const Frame F = phase_frame(F0); const int lane = F.lane, w = F.wave, tid = F.tid, r16 = lane & 15, g4 = lane >> 4;
    const bf16* Vb = RKV + 2 * (size_t)M * DM;
    const f32x4 Z = (f32x4){0.f, 0.f, 0.f, 0.f};
    for (int head = blockIdx.x; head < BATCH * 32; head += nrb) {
        const int b = head >> 5, hh = head & 31; const size_t m0 = (size_t)b * SEQ;
        const unsigned char* FRh = FR + (size_t)head * RF_NCH * RF_BYTES;
        const bool scanner = w < 4;
        const int lq = w - 4;
        auto ldma = [&](int c) {
            if (c % RF_ROUND == 0) {
                const int k = c / RF_ROUND; const unsigned need = (unsigned)(((RF_NCH - RF_ROUND * k) < RF_ROUND ? (RF_NCH - RF_ROUND * k) : RF_ROUND) * BATCH * 32);
                unsigned sp = 0;
                while ((unsigned)__builtin_amdgcn_readfirstlane((int)__hip_atomic_load(cnt + 64 * k, __ATOMIC_RELAXED, __HIP_MEMORY_SCOPE_AGENT)) < need) { __builtin_amdgcn_s_sleep(4); if (++sp > (1u << 22)) break; }
                __builtin_amdgcn_fence(__ATOMIC_ACQUIRE, "agent"); asm volatile("s_waitcnt vmcnt(0)" ::: "memory");
            }
            const unsigned char* s = FRh + (size_t)c * RF_BYTES; LAS unsigned char* d = F.lds + (c & 7) * RF_SLOT;
#pragma unroll
            for (int i = 0; i < 3; ++i) { const int p0 = lq * 64 + 256 * i;
                if (p0 + lane < RF_PIECES) __builtin_amdgcn_global_load_lds((const GAS unsigned*)(s + (size_t)(p0 + lane) * 16), (LAS unsigned*)(d + p0 * 16), 16, 0, 0); }
            if (lq == 3) {
#pragma unroll
                for (int i = 0; i < 2; ++i) { const int p = 64 * i + lane; const bf16* vs = Vb + (m0 + (size_t)c * 16 + (p >> 3)) * DM + hh * 64 + (p & 7) * 8;
                    __builtin_amdgcn_global_load_lds((const GAS unsigned*)vs, (LAS unsigned*)(d + RF_V + 1024 * i), 16, 0, 0); } }
            if (lq == 2) {
#pragma unroll
                for (int i = 0; i < 2; ++i) { const int p = 64 * i + lane; const bf16* gs = G + (m0 + (size_t)c * 16 + (p >> 3)) * DM + hh * 64 + (p & 7) * 8;
                    __builtin_amdgcn_global_load_lds((const GAS unsigned*)gs, (LAS unsigned*)(d + RF_G + 1024 * i), 16, 0, 0); } } };
        f32x4 st0 = Z, st1 = Z, st2 = Z, st3 = Z;
#define RF_WAIT5() do { if (lq < 2) asm volatile("s_waitcnt vmcnt(12)" ::: "memory"); else if (lq == 2) asm volatile("s_waitcnt vmcnt(20)" ::: "memory"); else asm volatile("s_waitcnt vmcnt(16)" ::: "memory"); } while (0)
        if (!scanner) { for (int c = 0; c < 6; ++c) ldma(c); RF_WAIT5(); }
        RW_BAR();
        int aoff0, aoff1, aoff2, aoff3;
        aoff0 = r16 * 128 + 16 * ((0 + (g4 >> 1)) ^ (r16 & 7)) + 8 * (g4 & 1); aoff1 = r16 * 128 + 16 * ((2 + (g4 >> 1)) ^ (r16 & 7)) + 8 * (g4 & 1);
        aoff2 = r16 * 128 + 16 * ((4 + (g4 >> 1)) ^ (r16 & 7)) + 8 * (g4 & 1); aoff3 = r16 * 128 + 16 * ((6 + (g4 >> 1)) ^ (r16 & 7)) + 8 * (g4 & 1);
#define RF_DECL(S) u32x4 a0##S, a1##S; u32x2 cak##S, cminv##S, bf0##S, bf1##S, bf2##S, bf3##S, kf0##S, kf1##S, kf2##S, kf3##S; f32x4 g0##S, g1##S, g2##S, g3##S; unsigned v01##S, v23##S;
#define RF_FETCH(c_, S) do { const LAS unsigned char* sl = F.lds + ((c_) & 7) * RF_SLOT; \
            const u32x2 x0 = *(const LAS u32x2*)(sl + RF_AT + aoff0), x1 = *(const LAS u32x2*)(sl + RF_AT + aoff1), x2 = *(const LAS u32x2*)(sl + RF_AT + aoff2), x3 = *(const LAS u32x2*)(sl + RF_AT + aoff3); \
            a0##S = (u32x4){x0.x, x0.y, x1.x, x1.y}; a1##S = (u32x4){x2.x, x2.y, x3.x, x3.y}; \
            const LAS u32x2* g4p = (const LAS u32x2*)(sl + RF_G4) + lane; cak##S = g4p[0]; cminv##S = g4p[64]; \
            const LAS u32x2* bfp = (const LAS u32x2*)(sl + RF_BF) + lane; bf0##S = bfp[0]; bf1##S = bfp[64]; bf2##S = bfp[128]; bf3##S = bfp[192]; \
            const LAS u32x2* kfp = (const LAS u32x2*)(sl + RF_KF) + lane; kf0##S = kfp[0]; kf1##S = kfp[64]; kf2##S = kfp[128]; kf3##S = kfp[192]; \
            const LAS f32x4* gtp = (const LAS f32x4*)(sl + RF_GT) + g4; g0##S = gtp[0]; g1##S = gtp[4]; g2##S = gtp[8]; g3##S = gtp[12]; \
            const LAS unsigned short* vl = (const LAS unsigned short*)(sl + RF_V) + (4 * g4) * 64 + 16 * w + r16; \
            v01##S = (unsigned)vl[0] | ((unsigned)vl[64] << 16); v23##S = (unsigned)vl[128] | ((unsigned)vl[192] << 16); } while (0)
#define RF_STEP(c_, S) do { u32x4 vw; vw.x = v01##S; vw.y = v23##S; vw.z = 0u; vw.w = 0u; const bf16x8 vf = __builtin_bit_cast(bf16x8, vw); \
            u32x4 s0w, s1w; s0w.x = cvtpk_s(st0[0], st0[1]); s0w.y = cvtpk_s(st0[2], st0[3]); s0w.z = cvtpk_s(st1[0], st1[1]); s0w.w = cvtpk_s(st1[2], st1[3]); \
            s1w.x = cvtpk_s(st2[0], st2[1]); s1w.y = cvtpk_s(st2[2], st2[3]); s1w.z = cvtpk_s(st3[0], st3[1]); s1w.w = cvtpk_s(st3[2], st3[3]); \
            const bf16x8 sb0 = __builtin_bit_cast(bf16x8, s0w), sb1 = __builtin_bit_cast(bf16x8, s1w); \
            f32x4 RHS = mfma16(__builtin_bit_cast(bf16x8, a0##S), sb0, Z); RHS = mfma16(__builtin_bit_cast(bf16x8, a1##S), sb1, RHS); RHS = mfma16(frag_u2(cak##S), vf, RHS); \
            const f32x4 Wt = mfma16(frag_u2(cminv##S), frag_lo4(RHS), Z); const bf16x8 wfr = frag_lo4(Wt); \
            { f32x4 D = mfma16(frag_u2(bf0##S), wfr, Z); D = mfma16(frag_u2(kf0##S), vf, D); st0 = (st0 + D) * g0##S; } \
            { f32x4 D = mfma16(frag_u2(bf1##S), wfr, Z); D = mfma16(frag_u2(kf1##S), vf, D); st1 = (st1 + D) * g1##S; } \
            { f32x4 D = mfma16(frag_u2(bf2##S), wfr, Z); D = mfma16(frag_u2(kf2##S), vf, D); st2 = (st2 + D) * g2##S; } \
            { f32x4 D = mfma16(frag_u2(bf3##S), wfr, Z); D = mfma16(frag_u2(kf3##S), vf, D); st3 = (st3 + D) * g3##S; } \
            const LAS unsigned char* sly = F.lds + ((c_) & 7) * RF_SLOT;        \
            const u32x2 y0 = *(const LAS u32x2*)(sly + RF_RT + aoff0), y1 = *(const LAS u32x2*)(sly + RF_RT + aoff1), y2 = *(const LAS u32x2*)(sly + RF_RT + aoff2), y3 = *(const LAS u32x2*)(sly + RF_RT + aoff3); \
            const LAS u32x2* g4y = (const LAS u32x2*)(sly + RF_G4) + lane; const u32x2 cbab_ = g4y[128], cbak_ = g4y[192]; \
            f32x4 Yt = mfma16(__builtin_bit_cast(bf16x8, (u32x4){y0.x, y0.y, y1.x, y1.y}), sb0, Z); Yt = mfma16(__builtin_bit_cast(bf16x8, (u32x4){y2.x, y2.y, y3.x, y3.y}), sb1, Yt); Yt = mfma16(frag_u2(cbab_), wfr, Yt); Yt = mfma16(frag_u2(cbak_), vf, Yt); \
            LAS float* yl = (LAS float*)(F.lds + RF_YL + ((c_) & 1) * 4096) + (4 * g4) * 64 + 16 * w + r16; \
            yl[0] = Yt[0]; yl[64] = Yt[1]; yl[128] = Yt[2]; yl[192] = Yt[3]; } while (0)
        const int lt = tid - 256, pt_ = lt >> 4, pcq = lt & 15;
        if (tid < 64) { ((LAS float*)(F.lds + RF_YL + 8192))[tid] = ln_w[hh * 64 + tid]; ((LAS float*)(F.lds + RF_YL + 8192 + 256))[tid] = ln_b[hh * 64 + tid]; }
#define RF_POST(c_) do { const LAS unsigned char* sp = F.lds + ((c_) & 7) * RF_SLOT; \
            const f32x4 y4 = *(const LAS f32x4*)(F.lds + RF_YL + ((c_) & 1) * 4096 + (pt_ * 64 + 4 * pcq) * 4); \
            const f32x4 lnw4 = *(const LAS f32x4*)(F.lds + RF_YL + 8192 + 16 * pcq), lnb4 = *(const LAS f32x4*)(F.lds + RF_YL + 8192 + 256 + 16 * pcq);        \
            const u32x2 vq = *(const LAS u32x2*)(sp + RF_V + (pt_ * 64 + 4 * pcq) * 2), gq = *(const LAS u32x2*)(sp + RF_G + (pt_ * 64 + 4 * pcq) * 2); const float bon = *(const LAS float*)(sp + RF_BON + pt_ * 4); \
            const float mean = row16_sum((y4[0] + y4[1]) + (y4[2] + y4[3])) * (1.f / 64.f); const f32x4 dlt = y4 - mean; \
            const float rstd = 1.f / sqrtf(row16_sum((dlt[0] * dlt[0] + dlt[1] * dlt[1]) + (dlt[2] * dlt[2] + dlt[3] * dlt[3])) * (1.f / 64.f) + 64e-5f); \
            const f32x4 vv = (f32x4){bf_lo(vq.x), bf_hi(vq.x), bf_lo(vq.y), bf_hi(vq.y)}, gg = (f32x4){bf_lo(gq.x), bf_hi(gq.x), bf_lo(gq.y), bf_hi(gq.y)}; \
            const f32x4 o4 = (dlt * rstd * lnw4 + lnb4 + vv * bon) * gg; u32x2 ow; ow.x = pk2(o4[0], o4[1]); ow.y = pk2(o4[2], o4[3]); \
            *(GAS u32x2*)(YG + (m0 + (size_t)(c_) * 16 + pt_) * DM + hh * 64 + 4 * pcq) = ow; } while (0)
        RF_DECL(A) RF_DECL(B)
        if (scanner) RF_FETCH(0, A);
        for (int c = 0; c < RF_NCH; c += 2) {
            if (scanner) { RF_FETCH(c + 1, B); RF_STEP(c, A); }
            else { if (c > 0) RF_POST(c - 1); if (c + 6 < RF_NCH) { ldma(c + 6); RF_WAIT5(); } else asm volatile("s_waitcnt vmcnt(0)" ::: "memory"); }
            RW_BAR();
            if (scanner) { if (c + 2 < RF_NCH) RF_FETCH(c + 2, A); RF_STEP(c + 1, B); }
            else { RF_POST(c); if (c + 7 < RF_NCH) { ldma(c + 7); RF_WAIT5(); } else asm volatile("s_waitcnt vmcnt(0)" ::: "memory"); }
            RW_BAR();
        }
        if (!scanner) RF_POST(RF_NCH - 1);
        RW_BAR();
#undef RF_POST
#undef RF_DECL
#undef RF_FETCH
#undef RF_STEP
    }
}

__device__ __forceinline__ void rwkv_post_phase(const Frame& F0, const bf16* RKV, const float* AV, const bf16* G, const float* Y, bf16* YG,
                                                const float* k_a, const float* r_k, const float* ln_w, const float* ln_b) {
    const Frame F = phase_frame(F0);
    const bf16* Rb = RKV; const bf16* Kb = RKV + (size_t)M * DM; const bf16* Vb = RKV + 2 * (size_t)M * DM;
    const int gt = blockIdx.x * 512 + F.tid, NT = F.G * 512;
    for (int idx = gt; idx < M * 256; idx += NT) {
        const size_t m = (size_t)(idx >> 8); const int col = (idx & 255) * 8;
        const size_t off = m * DM + col;
        const f32x4 y0 = *(const f32x4*)(Y + off), y1 = *(const f32x4*)(Y + off + 4), a0 = *(const f32x4*)(AV + off), a1 = *(const f32x4*)(AV + off + 4); const u32x4 gw = *(const u32x4*)(G + off);
        const u32x4 rw = *(const u32x4*)(Rb + off), kw = *(const u32x4*)(Kb + off), vw = *(const u32x4*)(Vb + off);
        float y[8], a[8], gg[8], r[8], k[8], v[8];
#pragma unroll
        for (int j = 0; j < 4; ++j) { y[j] = y0[j]; y[4 + j] = y1[j]; a[j] = a0[j]; a[4 + j] = a1[j]; gg[2 * j] = bf_lo(gw[j]); gg[2 * j + 1] = bf_hi(gw[j]);
            r[2 * j] = bf_lo(rw[j]); r[2 * j + 1] = bf_hi(rw[j]); k[2 * j] = bf_lo(kw[j]); k[2 * j + 1] = bf_hi(kw[j]); v[2 * j] = bf_lo(vw[j]); v[2 * j + 1] = bf_hi(vw[j]); }
        float s = 0.f, bon = 0.f;
#pragma unroll
        for (int j = 0; j < 8; ++j) { s += y[j]; const float kp = k[j] * (1.f + (a[j] - 1.f) * k_a[col + j]); bon += r[j] * kp * r_k[col + j]; }
        s += __shfl_xor(s, 1); s += __shfl_xor(s, 2); s += __shfl_xor(s, 4);
        bon += __shfl_xor(bon, 1); bon += __shfl_xor(bon, 2); bon += __shfl_xor(bon, 4);
        const float mean = s * (1.f / 64.f); float q = 0.f;
#pragma unroll
        for (int j = 0; j < 8; ++j) { const float dlt = y[j] - mean; q += dlt * dlt; }
        q += __shfl_xor(q, 1); q += __shfl_xor(q, 2); q += __shfl_xor(q, 4);
        const float rstd = 1.f / sqrtf(q * (1.f / 64.f) + 64e-5f);
        u32x4 o;
#pragma unroll
        for (int j = 0; j < 4; ++j) { float e0 = ((y[2 * j] - mean) * rstd * ln_w[col + 2 * j] + ln_b[col + 2 * j] + bon * v[2 * j]) * gg[2 * j];
            float e1 = ((y[2 * j + 1] - mean) * rstd * ln_w[col + 2 * j + 1] + ln_b[col + 2 * j + 1] + bon * v[2 * j + 1]) * gg[2 * j + 1]; o[j] = pk2(e0, e1); }
        *(u32x4*)(YG + off) = o;
    }
}

constexpr int PH_PER_LAYER = 12, PH_FINAL = DEPTH * PH_PER_LAYER, PH_END = PH_FINAL + 1;
struct Args { const float* in[34]; float* out; unsigned char* ws; int ph_lo, ph_hi; };
#define IN(k) (lo <= (k) && (k) < hi)
#define SEAM(k) do { if ((k) > lo) xcd_barrier(bar); } while (0)
#define PH_BEGIN int z_ = 0; asm volatile("" : "+s"(z_)); unsigned char* ws = args.ws + (size_t)(unsigned)z_;     int bid = blockIdx.x; asm volatile("" : "+s"(bid)); \
    float* out = args.out; bf16* H = (bf16*)(ws + WS_H); bf16* XR = (bf16*)(ws + WS_XR); unsigned char* big = ws + WS_BIG; LAS unsigned char* ring = F.lds; (void)H; (void)XR; (void)big; (void)ring; (void)out; (void)bid
#define AIN(k) (args.in[(k) + z_])
#define SSQ(k) ((pg8::ssq_t*)(ws + WS_CTL + CTL_SSQ) + (size_t)(k) * M)
template <int layer> __device__ __forceinline__ void layer_body(const Args& args, const Frame& F, const XcdBarrier& bar, const int lo, const int hi) {
        constexpr int kind = layer % 3, pb = layer * PH_PER_LAYER, li = layer / 3;
#define CVT_MIX_ATTN(L) do { \
            cvt_mat(F, AIN(4) + (size_t)((L) / 3) * DM * NQKV, NQKV, DM, NQKV, DM, NQKV, (bf16*)(ws + WS_W + W_QKV), DM, 0, 0, AIN(1) + (size_t)(L) * DM, (L) == 0 ? 0 : 1, 0);     \
            cvt_mat(F, AIN(5) + (size_t)((L) / 3) * DM * DM, DM, DM, DM, DM, DM, (bf16*)(ws + WS_W + W_AO), DM, 0, 0, nullptr, 0, 0); } while (0)
#define CVT_MIX_S5(L) do { \
            cvt_mat(F, AIN(6) + (size_t)((L) / 3) * DM * DM, DM, DM, DM, DM, DM, (bf16*)(ws + WS_W + W_SIN), DM, 0, 0, AIN(1) + (size_t)(L) * DM, 1, 0); \
            cvt_mat(F, AIN(15) + (size_t)((L) / 3) * DM * 2 * DM, 2 * DM, DM, 2 * DM, DM, 2 * DM, (bf16*)(ws + WS_W + W_SOUT), DM, 0, 0, nullptr, 0, 1); \
            __syncthreads(); \
            s5_precompute(F, AIN(7) + (size_t)((L) / 3) * 128, AIN(8) + (size_t)((L) / 3) * 8192, AIN(9) + (size_t)((L) / 3) * 8192, AIN(10) + (size_t)((L) / 3) * 131072, AIN(11) + (size_t)((L) / 3) * 131072, \
                          AIN(12) + (size_t)((L) / 3) * 131072, AIN(13) + (size_t)((L) / 3) * 131072, AIN(14) + (size_t)((L) / 3) * 2048, (bf16*)(ws + WS_W + W_SY), (bf16*)(ws + WS_W + W_SF)); \
            __syncthreads(); } while (0)
#define CVT_MLP(L) do { \
            cvt_mat(F, AIN(32) + (size_t)(L) * DM * FF, FF, DM, FF, DM, FF, (bf16*)(ws + WS_W + W_M1), DM, 0, 0, AIN(2) + (size_t)(L) * DM, 1, 0); \
            cvt_mat(F, AIN(33) + (size_t)(L) * FF * DM, DM, FF, DM, FF, DM, (bf16*)(ws + WS_W + W_M2), FF, 0, 0, nullptr, 0, 0); } while (0)
        constexpr bool own0 = (layer == 0 || kind == 2), next_own0 = (layer + 1 >= DEPTH) || (layer + 1 == 0 || (layer + 1) % 3 == 2);
        if (own0 && IN(pb + 0)) { SEAM(pb + 0); PH_BEGIN; REP(1) {
            if (kind == 0) CVT_MIX_ATTN(layer);
            else if (kind == 1) CVT_MIX_S5(layer);
            else {
                bf16* Wf = (bf16*)(ws + WS_W + W_RF);
                for (int j = 0; j < 6; ++j) {
                    const float* wsrc = j < 3 ? AIN(17) + ((size_t)li * 3 + j) * DM * DM : (j == 3 ? AIN(19) + (size_t)li * DM * 96 : (j == 4 ? AIN(22) + (size_t)li * DM * 96 : AIN(24) + (size_t)li * DM * 256));
                    const int nsrc = j < 3 ? DM : (j < 5 ? 96 : 256), npad = j < 3 ? DM : 256, drow = j < 3 ? j * DM : 6144 + (j - 3) * 256;
                    cvt_mat(F, wsrc, nsrc, DM, nsrc, DM, npad, Wf, DM, drow, 0, nullptr, 0, 0);
                }
                for (int j = 0; j < 3; ++j) {
                    const float* wsrc = j == 0 ? AIN(20) + (size_t)li * 96 * DM : (j == 1 ? AIN(23) + (size_t)li * 96 * DM : AIN(25) + (size_t)li * 256 * DM);
                    cvt_mat(F, wsrc, DM, j < 2 ? 96 : 256, DM, 256, DM, (bf16*)(ws + WS_W + W_R2W + (size_t)j * MiB), 256, 0, 0, nullptr, 0, 0);
                }
                cvt_mat(F, AIN(31) + (size_t)li * DM * DM, DM, DM, DM, DM, DM, (bf16*)(ws + WS_W + W_RO), DM, 0, 0, nullptr, 0, 0);
            }
            CVT_MLP(layer);
            if (kind == 2) norm_rows_rwkv(F, XR, AIN(1) + (size_t)layer * DM, AIN(16) + (size_t)li * 6 * DM, (bf16*)(big + B_X6));
            else if (layer == 0) norm_rows(F, AIN(0), false, AIN(1) + (size_t)layer * DM, H, nullptr, 0);
        } }
        if (kind == 0) {
            if (IN(pb + 1)) { SEAM(pb + 1); PH_BEGIN;
                if (!own0) { CVT_MLP(layer); __syncthreads(); }
                pg8::Gemm g{layer == 0 ? H : XR, (const bf16*)(ws + WS_W + W_QKV), M, NQKV, DM, DM, DM}; pg8::StaticOrder S; S.init(M, NQKV, F.G, bid);
                pg8::EpiBf16<0> E{(bf16*)(big + B_QKV), NQKV, layer == 0 ? (const pg8::ssq_t*)nullptr : (const pg8::ssq_t*)SSQ((2 * layer + 7) % 8)}; REP(2) pg8::gemm_phase(ring, F.wave, g, S, E); }
            if (IN(pb + 2)) { SEAM(pb + 2); PH_BEGIN;
#ifndef NO_ATTN
                REP(3) attn_phase(F, (const bf16*)(big + B_QKV), (float*)(big + B_LSE), (bf16*)(big + B_OG));
#endif
            }
            if (IN(pb + 3)) { SEAM(pb + 3); PH_BEGIN; REP(1) attn_merge_phase(F, (const bf16*)(big + B_OG), (const float*)(big + B_LSE), H); }
            if (IN(pb + 4)) { SEAM(pb + 4); PH_BEGIN;
                pg8::Gemm g{H, (const bf16*)(ws + WS_W + W_AO), M, DM, DM, DM, DM}; pg8::StaticOrder S; S.init(M, DM, F.G, bid);
                pg8::EpiResB<layer == 0> E{layer == 0 ? (const void*)AIN(0) : (const void*)XR, XR, SSQ(2 * layer)};  pg8::gemm_phase(ring, F.wave, g, S, E); }
        } else if (kind == 1) {
            if (IN(pb + 1)) { SEAM(pb + 1); PH_BEGIN;
                if (!own0) { CVT_MLP(layer); __syncthreads(); }
                pg8::Gemm g{XR, (const bf16*)(ws + WS_W + W_SIN), M, DM, DM, DM, DM}; pg8::StaticOrder S; S.init(M, DM, F.G, bid);
                pg8::EpiS5U16 E{(bf16*)(big + B_U), (const pg8::ssq_t*)SSQ((2 * layer + 7) % 8)}; REP(2) pg8::gemm_phase(ring, F.wave, g, S, E); }
            if (IN(pb + 2)) { SEAM(pb + 2); PH_BEGIN; REP(0) {
                for (int pair = bid; pair < 256; pair += F.G) { pg8::PairOrder S{pair}; bf16* U16 = (bf16*)(big + B_U); float* XO = (float*)(big + B_XO);
                    { pg8::Gemm g{U16, (const bf16*)(ws + WS_W + W_SF), 131072, 256, 256, 512, 256}; pg8::EpiS5F E{XO}; pg8::gemm_phase(ring, F.wave, g, S, E); }
                    VM_WAIT(); __syncthreads(); __builtin_amdgcn_fence(__ATOMIC_ACQUIRE, "agent"); VM_WAIT();
                    s5_chunk_scan(phase_frame(F), pair, XO, U16, AIN(7) + (size_t)li * 128, AIN(8) + (size_t)li * 8192, AIN(9) + (size_t)li * 8192);
                    VM_WAIT(); __syncthreads(); __builtin_amdgcn_fence(__ATOMIC_ACQUIRE, "agent"); VM_WAIT();
                    { pg8::Gemm g{U16, (const bf16*)(ws + WS_W + W_SY), 131072, 256, 384, 512, 384}; pg8::EpiS5Y E{H}; pg8::gemm_phase(ring, F.wave, g, S, E); } } } }
            if (IN(pb + 3)) { SEAM(pb + 3); PH_BEGIN;
                pg8::Gemm g{H, (const bf16*)(ws + WS_W + W_SOUT), M, 2 * DM, DM, DM, DM}; pg8::StaticOrder S; S.init(M, 2 * DM, F.G, bid);
                pg8::EpiGluRes E{XR, SSQ(2 * layer)};  pg8::gemm_phase(ring, F.wave, g, S, E); }
        } else {
            if (IN(pb + 1)) { SEAM(pb + 1); PH_BEGIN;
                pg8::Gemm g{(const bf16*)(big + B_X6), (const bf16*)(ws + WS_W + W_RF), M, NRW1, DM, DM, DM}; pg8::RwkvOrder S; S.init(M, NRW1, F.G, bid);
                pg8::EpiRwkv1 E{(bf16*)(big + B_RKV), (bf16*)(big + B_LORA)}; REP(2) pg8::gemm_phase(ring, F.wave, g, S, E); }
            if (IN(pb + 2)) { SEAM(pb + 2); PH_BEGIN;
                pg8::StaticOrder S; S.init(M, DM, F.G, bid); const bf16* LORA = (const bf16*)(big + B_LORA); REP(2) {
                { pg8::Gemm g{LORA, (const bf16*)(ws + WS_W + W_R2W), M, DM, 256, 768, 256}; pg8::EpiBiasF32<1> E{(float*)(big + B_DEC), AIN(18) + (size_t)li * DM}; pg8::gemm_phase(ring, F.wave, g, S, E); }
                { pg8::Gemm g{LORA + 256, (const bf16*)(ws + WS_W + W_R2A), M, DM, 256, 768, 256}; pg8::EpiSigBf16 E{(bf16*)(big + B_AV), DM, AIN(21) + (size_t)li * DM}; pg8::gemm_phase(ring, F.wave, g, S, E); }
                { pg8::Gemm g{LORA + 512, (const bf16*)(ws + WS_W + W_R2G), M, DM, 256, 768, 256}; pg8::EpiBf16<0> E{(bf16*)(big + B_G), DM, nullptr}; pg8::gemm_phase(ring, F.wave, g, S, E); } } }
            if (IN(pb + 3)) { SEAM(pb + 3); PH_BEGIN;
                const int nrb = F.G >= 128 ? 64 : (F.G >= 8 ? F.G / 4 : 1); unsigned* cnt = (unsigned*)(ws + WS_CTL) + CW_RFCNT;
                if ((int)blockIdx.x < nrb) rwkv_chunk_scan_phase(F, big + B_FR, (const bf16*)(big + B_RKV), (const bf16*)(big + B_G), H, AIN(29) + (size_t)li * DM, AIN(30) + (size_t)li * DM, nrb, cnt);
                else rwkv_frames_phase(F, (const bf16*)(big + B_RKV), (const float*)(big + B_DEC), (const bf16*)(big + B_AV), AIN(26) + (size_t)li * DM, AIN(27) + (size_t)li * DM, AIN(28) + (size_t)li * DM, big + B_FR, nrb * NWAVES, (F.G - nrb) * NWAVES, cnt); }
            if (IN(pb + 6)) { SEAM(pb + 6); PH_BEGIN;
                pg8::Gemm g{H, (const bf16*)(ws + WS_W + W_RO), M, DM, DM, DM, DM}; pg8::StaticOrder S; S.init(M, DM, F.G, bid);
                pg8::EpiResB<false> E{(const void*)XR, XR, SSQ(2 * layer)}; pg8::gemm_phase(ring, F.wave, g, S, E); }
        }
        if (IN(pb + 7)) { SEAM(pb + 7); PH_BEGIN;
            pg8::Gemm g{XR, (const bf16*)(ws + WS_W + W_M1), M, FF, DM, DM, DM}; pg8::StaticOrder S; S.init(M, FF, F.G, bid);
            pg8::EpiBf16<1> E{(bf16*)(big + B_HID), FF, (const pg8::ssq_t*)SSQ(2 * layer)}; REP(2) pg8::gemm_phase(ring, F.wave, g, S, E); }
        if (IN(pb + 8)) { SEAM(pb + 8); PH_BEGIN;
            if (!next_own0) { if ((layer + 1) % 3 == 0) CVT_MIX_ATTN(layer + 1); else CVT_MIX_S5(layer + 1); __syncthreads(); }
            pg8::Gemm g{(const bf16*)(big + B_HID), (const bf16*)(ws + WS_W + W_M2), M, DM, FF, FF, FF}; pg8::StaticOrder S; S.init(M, DM, F.G, bid);
            pg8::EpiResB<false> E{(const void*)XR, XR, SSQ(2 * layer + 1)};  pg8::gemm_phase(ring, F.wave, g, S, E); }
    }
__global__ void __launch_bounds__(NWAVES * 64, 2) trunk_fwd(Args args) {
    extern __shared__ __attribute__((aligned(16))) unsigned char lds_raw[];
    Frame F;
    F.lds = (LAS unsigned char*)lds_raw;
    F.wave = __builtin_amdgcn_readfirstlane((int)threadIdx.x >> 6); F.lane = 0; F.tid = 0;
    F.G = gridDim.x; F.gw = blockIdx.x * NWAVES + F.wave; F.NGW = F.G * NWAVES;
    volatile LAS unsigned* MISC = (volatile LAS unsigned*)(F.lds + MISC_OFF);
    if (threadIdx.x < 16) MISC[threadIdx.x] = 0u;
    __syncthreads();
    unsigned* ctl = (unsigned*)(args.ws + WS_CTL);
    const int lo = args.ph_lo, hi = args.ph_hi;
    XcdBarrier bar; bar.bar = ctl + CW_BAR; bar.x = 0; bar.st = MISC + 8; bar.wave = F.wave;
    if (hi - lo > 1) bar = xcd_barrier_post(ctl + CW_BAR, MISC + 8, F.wave);
    layer_body<0>(args, F, bar, lo, hi); layer_body<1>(args, F, bar, lo, hi); layer_body<2>(args, F, bar, lo, hi); layer_body<3>(args, F, bar, lo, hi);
    if (IN(PH_FINAL)) { SEAM(PH_FINAL); PH_BEGIN; norm_rows(F, XR, true, AIN(3), nullptr, out, 2); }
#undef PH_BEGIN
#undef AIN
#undef IN
#undef SEAM
}

static bool phase_used(int p) {
    if (p == PH_FINAL) return true;
    const int layer = p / PH_PER_LAYER, slot = p % PH_PER_LAYER, kind = layer % 3;
    if (slot == 0) return layer == 0 || kind == 2;
    if (slot >= 7 && slot <= 8) return true;
    if (slot >= 1 && slot <= 6) { if (kind == 2) return slot <= 3 || slot == 6; const int n = kind == 0 ? 4 : 3; return slot <= n; }
    return false;
}
extern "C" void kernel_launch(void* const* d_in, const int* in_sizes, int n_in, void* d_out, int out_size, void* d_ws, size_t ws_size, hipStream_t stream) {
    static int grid = 0;
    if (grid == 0) {
        if (n_in != 34 || in_sizes[0] != M * DM || out_size != M * DM || ws_size < WS_END) { fprintf(stderr, "kernel_launch: unexpected shapes / workspace (n_in %d, ws %zu, need %zu); nothing launched\n", n_in, ws_size, (size_t)WS_END); grid = -1; return; }
        int dev = 0, cus = 0, per_cu = 0;
        if (hipGetDevice(&dev) != hipSuccess || hipDeviceGetAttribute(&cus, hipDeviceAttributeMultiprocessorCount, dev) != hipSuccess) { grid = -1; return; }
        if (hipFuncSetAttribute((const void*)trunk_fwd, hipFuncAttributeMaxDynamicSharedMemorySize, LDS_BYTES) != hipSuccess) { fprintf(stderr, "kernel_launch: hipFuncSetAttribute failed\n"); grid = -1; return; }
        if (hipOccupancyMaxActiveBlocksPerMultiprocessor(&per_cu, (const void*)trunk_fwd, NWAVES * 64, LDS_BYTES) != hipSuccess || per_cu < 1) { fprintf(stderr, "kernel_launch: occupancy query says %d blocks per CU\n", per_cu); (void)hipGetLastError(); grid = -1; return; }
        grid = cus;
    }
    if (grid < 0) return;
    if (hipMemsetAsync((char*)d_ws + WS_CTL, 0, CTL_ZERO_BYTES, stream) != hipSuccess) return;
    Args a{};
    for (int i = 0; i < 34; ++i) a.in[i] = (const float*)d_in[i];
    a.out = (float*)d_out; a.ws = (unsigned char*)d_ws;
#if MK_N_LAUNCHES == 1
    a.ph_lo = 0; a.ph_hi = PH_END;
    hipLaunchKernelGGL(trunk_fwd, dim3(grid), dim3(NWAVES * 64), LDS_BYTES, stream, a);
#else
    for (int p = 0; p < PH_END; ++p) { if (!phase_used(p)) continue; a.ph_lo = p; a.ph_hi = p + 1;
        hipLaunchKernelGGL(trunk_fwd, dim3(grid), dim3(NWAVES * 64), LDS_BYTES, stream, a); }
#endif
    const hipError_t le = hipPeekAtLastError();
    if (le != hipSuccess) fprintf(stderr, "kernel_launch: launch failed: %s\n", hipGetErrorName(le));
}
```

```cpp
#include <hip/hip_runtime.h>
#include <cstdio>
#include <cstdint>

#ifndef MK_N_LAUNCHES
#define MK_N_LAUNCHES 1
#endif

#ifndef PROBE_DUP
#define PROBE_DUP 0
#endif
#define REP(bit) for (int rep_ = 0; rep_ < ((PROBE_DUP >> (bit)) & 1) + 1; ++rep_)
#define LAS __attribute__((address_space(3)))
#define GAS __attribute__((address_space(1)))
typedef unsigned short bf16;
typedef short bf16x8 __attribute__((ext_vector_type(8)));
typedef short s16x4 __attribute__((ext_vector_type(4)));
typedef float f32x4 __attribute__((ext_vector_type(4)));
typedef float f32x2 __attribute__((ext_vector_type(2)));
typedef unsigned u32x4 __attribute__((ext_vector_type(4)));
typedef unsigned u32x2 __attribute__((ext_vector_type(2)));

constexpr int BATCH = 2, SEQ = 8192, DM = 2048, FF = 8192, DEPTH = 4;
constexpr int M = BATCH * SEQ;
constexpr int NQKV = 18432;
constexpr int NRW1 = 6912;
constexpr float NORM_EPS = 1e-5f;
constexpr int NWAVES = 8;

__device__ __forceinline__ float frcp(float x) { return __builtin_amdgcn_rcpf(x); }

namespace pg8 {
constexpr int BM = 256, BK = 64, HALF = 128, HTB = HALF * BK * 2, STAGE_BYTES = 8 * HTB, NXCD = 8, WGM = 8;
__host__ __device__ __forceinline__ int lds_byte(int r, int c) { const int st = (r >> 4) * 2 + (c >> 5), rr = r & 15, cc = c & 31, ob = rr * 64 + cc * 2; return st * 1024 + (ob ^ (((ob >> 9) & 1) << 5)); }
__host__ __device__ __forceinline__ void stage_rc(int b, int& R, int& C) { const int st = b / 1024, sb = b % 1024, swz = sb ^ (((sb >> 9) & 1) << 5); R = (st >> 1) * 16 + swz / 64; C = (st & 1) * 32 + (swz % 64) / 2; }
__host__ __device__ __forceinline__ int perm32(int rho) { const int n = rho >> 4, i = rho & 15; return 8 * (i >> 2) + 4 * n + (i & 3); }

struct Unit { int pm, pn; };
struct Gemm { const bf16* A; const bf16* Bt; int M, N, K, lda, ldb; };

struct StaticOrder {
    int nM, nN, nwg, G, c;
    __device__ void init(int M_, int N_, int G_, int c_) { nM = M_ / BM; nN = N_ / BM; nwg = nM * nN; G = G_; c = c_; }
    __device__ bool next(int i, Unit& u) const {
        const long L = (long)i * G + c; if (L >= nwg) return false;
        int wgid = (int)L; { const int q = nwg / NXCD, r = nwg % NXCD, xcd = wgid % NXCD, off = wgid / NXCD; wgid = (xcd < r ? xcd * (q + 1) : r * (q + 1) + (xcd - r) * q) + off; }
        const int nig = WGM * nN, gid = wgid / nig, fm = gid * WGM, gsz = (nM - fm) < WGM ? (nM - fm) : WGM;
        u.pm = fm + ((wgid % nig) % gsz); u.pn = (wgid % nig) / gsz; return true;
    }
    __device__ __forceinline__ size_t a_off(const Unit&) const { return 0; }
};
struct RwkvOrder : StaticOrder {
    __device__ __forceinline__ size_t a_off(const Unit& u) const { const int idx = u.pn < 24 ? (u.pn >> 3) : (u.pn - 21); return (size_t)idx * ((size_t)M * DM * 2); }
};
__device__ __forceinline__ unsigned cvt_pk_bf16(float lo, float hi) { unsigned r; asm volatile("v_cvt_pk_bf16_f32 %0, %1, %2" : "=v"(r) : "v"(lo), "v"(hi)); return r; }

typedef f32x4 Acc[2][2][4][2];

typedef unsigned long long ssq_t;
__device__ __forceinline__ float row_rstd(const ssq_t* ssq, int row) { return ssq ? 1.f / sqrtf((float)ssq[row] * (1.f / 1048576.f) * (1.f / DM) + NORM_EPS) : 1.f; }
struct RstdTab { const ssq_t* ssq; LAS float* tab; int pm0; };
__device__ __forceinline__ RstdTab rstd_prepare(const ssq_t* ssq, LAS unsigned char* lds, int pm0, int tid) {
    RstdTab t; t.ssq = ssq; t.tab = (LAS float*)(lds + STAGE_BYTES); t.pm0 = pm0;
    if (ssq && tid < 256) t.tab[tid] = row_rstd(ssq, pm0 * BM + tid);
    return t;
}
__device__ __forceinline__ float rstd_get(const RstdTab& t, int pm, int rloc) { return !t.ssq ? 1.f : (pm == t.pm0 ? t.tab[rloc] : row_rstd(t.ssq, pm * BM + rloc)); }
__device__ __forceinline__ u32x4 to_store_layout(const u32x4 w, int lane) {
    const int src = (((lane & 3) << 4) | (lane >> 2)) << 2; u32x4 o;
    o.x = (unsigned)__builtin_amdgcn_ds_bpermute(src, (int)w.x); o.y = (unsigned)__builtin_amdgcn_ds_bpermute(src, (int)w.y);
    o.z = (unsigned)__builtin_amdgcn_ds_bpermute(src, (int)w.z); o.w = (unsigned)__builtin_amdgcn_ds_bpermute(src, (int)w.w); return o;
}
template <int ACT  > struct EpiBf16 {
    static constexpr bool PERM = true, PREP = true;
    bf16* O; int ldc; const ssq_t* ssq; RstdTab rt;
    __device__ __forceinline__ void prep(LAS unsigned char* lds, int pm0, int tid) { rt = rstd_prepare(ssq, lds, pm0, tid); }
    __device__ __forceinline__ void operator()(const Acc& acc, const Unit& u, int wr, int wc, int fr, int fq) const {
        const int lane = fq * 16 + fr, sr = lane >> 2, sq = lane & 3;
        const int row0 = u.pm * BM + wr * 64 + sr, col0 = u.pn * BM + wc * 32 + 8 * sq;
#pragma unroll
        for (int ai = 0; ai < 2; ++ai)
#pragma unroll
            for (int m = 0; m < 4; ++m) { bf16* rowp = O + (size_t)(row0 + ai * HALF + m * 16) * ldc + col0; const float rs = rstd_get(rt, u.pm, wr * 64 + fr + ai * HALF + m * 16);
#pragma unroll
                for (int bj = 0; bj < 2; ++bj) { f32x4 v0 = acc[ai][bj][m][0] * rs, v1 = acc[ai][bj][m][1] * rs;
                    if (ACT == 1) { const f32x4 z4 = (f32x4){0.f, 0.f, 0.f, 0.f};
                        const f32x4 m0 = __builtin_elementwise_max(v0, z4), m1 = __builtin_elementwise_max(v1, z4); v0 = m0 * m0; v1 = m1 * m1; }
                    u32x4 w; w.x = cvt_pk_bf16(v0[0], v0[1]); w.y = cvt_pk_bf16(v0[2], v0[3]); w.z = cvt_pk_bf16(v1[0], v1[1]); w.w = cvt_pk_bf16(v1[2], v1[3]);
                    *(u32x4*)(rowp + bj * HALF) = to_store_layout(w, lane); } }
    }
};
__device__ __forceinline__ void row_ssq_add(ssq_t* ssq, int row, float s, int fq) {
    s += __shfl_xor(s, 16); s += __shfl_xor(s, 32);
    if (fq == 0) atomicAdd(ssq + row, (ssq_t)(s * 1048576.f));
}
__device__ __forceinline__ float sq8(const u32x4 w) { float s = 0.f;
#pragma unroll
    for (int j = 0; j < 4; ++j) { const float lo = __builtin_bit_cast(float, w[j] << 16), hi = __builtin_bit_cast(float, w[j] & 0xffff0000u); s += lo * lo + hi * hi; } return s; }
template <bool RF32> struct EpiResB {
    static constexpr bool PERM = true, PREP = false;
    const void* resid; bf16* out; ssq_t* ssq;
    __device__ __forceinline__ void operator()(const Acc& acc, const Unit& u, int wr, int wc, int fr, int fq) const {
        const int row0 = u.pm * BM + wr * 64 + fr, col0 = u.pn * BM + wc * 32 + 8 * fq;
        f32x4 rf[2][4]; u32x4 rb[2][2]; float ssum[8];
#define RES_LOAD(i_, b_) do { const size_t off_ = (size_t)(row0 + ((i_) >> 2) * HALF + ((i_) & 3) * 16) * DM + col0; \
            if (RF32) { rf[b_][0] = *(const f32x4*)((const float*)resid + off_); rf[b_][1] = *(const f32x4*)((const float*)resid + off_ + 4); \
                        rf[b_][2] = *(const f32x4*)((const float*)resid + off_ + HALF); rf[b_][3] = *(const f32x4*)((const float*)resid + off_ + HALF + 4); } \
            else { rb[b_][0] = *(const u32x4*)((const bf16*)resid + off_); rb[b_][1] = *(const u32x4*)((const bf16*)resid + off_ + HALF); } } while (0)
        RES_LOAD(0, 0);
#pragma unroll
        for (int i = 0; i < 8; ++i) { const int ai = i >> 2, m = i & 3, b = i & 1; const size_t off = (size_t)(row0 + ai * HALF + m * 16) * DM + col0; float s = 0.f;
            if (i + 1 < 8) { if (b == 0) RES_LOAD(i + 1, 1); else RES_LOAD(i + 1, 0); }
#pragma unroll
            for (int bj = 0; bj < 2; ++bj) { f32x4 r0, r1;
                if (RF32) { r0 = rf[b][2 * bj]; r1 = rf[b][2 * bj + 1]; }
                else { const u32x4 rw = rb[b][bj];
                    r0 = (f32x4){__builtin_bit_cast(float, rw[0] << 16), __builtin_bit_cast(float, rw[0] & 0xffff0000u), __builtin_bit_cast(float, rw[1] << 16), __builtin_bit_cast(float, rw[1] & 0xffff0000u)};
                    r1 = (f32x4){__builtin_bit_cast(float, rw[2] << 16), __builtin_bit_cast(float, rw[2] & 0xffff0000u), __builtin_bit_cast(float, rw[3] << 16), __builtin_bit_cast(float, rw[3] & 0xffff0000u)}; }
                const f32x4 o0 = r0 + acc[ai][bj][m][0], o1 = r1 + acc[ai][bj][m][1];
                u32x4 w; w.x = cvt_pk_bf16(o0[0], o0[1]); w.y = cvt_pk_bf16(o0[2], o0[3]); w.z = cvt_pk_bf16(o1[0], o1[1]); w.w = cvt_pk_bf16(o1[2], o1[3]);
                *(u32x4*)(out + off + bj * HALF) = w; s += sq8(w); }
            s += __shfl_xor(s, 16); s += __shfl_xor(s, 32); ssum[i] = s; }
#undef RES_LOAD
        if (fq == 0) {
#pragma unroll
            for (int i = 0; i < 8; ++i) atomicAdd(ssq + row0 + (i >> 2) * HALF + (i & 3) * 16, (ssq_t)(ssum[i] * 1048576.f)); }
    }
};
struct EpiGluRes {
    static constexpr bool PERM = true, PREP = false;
    bf16* out; ssq_t* ssq;
    __device__ __forceinline__ void operator()(const Acc& acc, const Unit& u, int wr, int wc, int fr, int fq) const {
        const int row0 = u.pm * BM + wr * 64 + fr, col0 = u.pn * HALF + wc * 32 + 8 * fq;
        u32x4 rb[2]; float ssum[8];
        rb[0] = *(const u32x4*)(out + (size_t)row0 * DM + col0);
#pragma unroll
        for (int i = 0; i < 8; ++i) { const int ai = i >> 2, m = i & 3; const int row = row0 + ai * HALF + m * 16; const size_t off = (size_t)row * DM + col0;
                if (i + 1 < 8) rb[(i + 1) & 1] = *(const u32x4*)(out + (size_t)(row0 + ((i + 1) >> 2) * HALF + ((i + 1) & 3) * 16) * DM + col0);
                const u32x4 rw = rb[i & 1]; float r[8], o[8];
#pragma unroll
                for (int j = 0; j < 4; ++j) { r[2 * j] = __builtin_bit_cast(float, rw[j] << 16); r[2 * j + 1] = __builtin_bit_cast(float, rw[j] & 0xffff0000u); }
#pragma unroll
                for (int n = 0; n < 2; ++n)
#pragma unroll
                    for (int j = 0; j < 4; ++j) { const float v = acc[ai][0][m][n][j], g = acc[ai][1][m][n][j]; o[4 * n + j] = r[4 * n + j] + v * frcp(1.f + __expf(-g)); }
                u32x4 w; w.x = cvt_pk_bf16(o[0], o[1]); w.y = cvt_pk_bf16(o[2], o[3]); w.z = cvt_pk_bf16(o[4], o[5]); w.w = cvt_pk_bf16(o[6], o[7]);
                { const int lane_ = fq * 16 + fr;
                  *(u32x4*)(out + (size_t)(u.pm * BM + wr * 64 + (lane_ >> 2) + ai * HALF + m * 16) * DM + u.pn * HALF + wc * 32 + 8 * (lane_ & 3)) = to_store_layout(w, lane_); }
                float s = sq8(w); s += __shfl_xor(s, 16); s += __shfl_xor(s, 32); ssum[i] = s; }
        if (fq == 0) {
#pragma unroll
            for (int i = 0; i < 8; ++i) atomicAdd(ssq + row0 + (i >> 2) * HALF + (i & 3) * 16, (ssq_t)(ssum[i] * 1048576.f)); }
    }
};
struct EpiS5U16 {
    static constexpr bool PERM = true, PREP = true;
    bf16* U16; const ssq_t* ssq; RstdTab rt;
    __device__ __forceinline__ void prep(LAS unsigned char* lds, int pm0, int tid) { rt = rstd_prepare(ssq, lds, pm0, tid); }
    __device__ __forceinline__ void operator()(const Acc& acc, const Unit& u, int wr, int wc, int fr, int fq) const {
        const int row0 = u.pm * BM + wr * 64 + fr, col0 = u.pn * BM + wc * 32 + 8 * fq;
#pragma unroll
        for (int ai = 0; ai < 2; ++ai)
#pragma unroll
            for (int m = 0; m < 4; ++m) { const int row = row0 + ai * HALF + m * 16, b = row >> 13, t = row & 8191; const float rs = rstd_get(rt, u.pm, wr * 64 + fr + ai * HALF + m * 16);
#pragma unroll
                for (int bj = 0; bj < 2; ++bj) { const int col = col0 + bj * HALF, g = col >> 4, c0 = col & 15; const f32x4 v0 = acc[ai][bj][m][0] * rs, v1 = acc[ai][bj][m][1] * rs;
                    u32x4 w; w.x = cvt_pk_bf16(v0[0], v0[1]); w.y = cvt_pk_bf16(v0[2], v0[3]); w.z = cvt_pk_bf16(v1[0], v1[1]); w.w = cvt_pk_bf16(v1[2], v1[3]);
                    *(u32x4*)(U16 + ((((size_t)(b * 128 + g) * 512 + (t >> 4)) * 512) + (t & 15) * 16 + c0)) = w; } }
    }
};
struct EpiS5F {
    static constexpr bool PERM = false, PREP = false;
    float* X;
    __device__ __forceinline__ void operator()(const Acc& acc, const Unit& u, int wr, int wc, int fr, int fq) const {
        const int row0 = u.pm * BM + wr * 64 + fr, col0 = wc * 32 + 4 * fq;
#pragma unroll
        for (int ai = 0; ai < 2; ++ai)
#pragma unroll
            for (int m = 0; m < 4; ++m)
#pragma unroll
                for (int n = 0; n < 2; ++n) *(f32x4*)(X + (size_t)(row0 + ai * HALF + m * 16) * 128 + col0 + n * 16) = acc[ai][0][m][n];
    }
};
__device__ __forceinline__ float gelu_tanh_e(float y) { const float z = 0.7978845608028654f * (y + 0.044715f * y * y * y); const float t = 1.f - 2.f * frcp(__expf(2.f * z) + 1.f); return 0.5f * y * (1.f + t); }
struct EpiS5Y {
    static constexpr bool PERM = true, PREP = false;
    bf16* YS;
    __device__ __forceinline__ void operator()(const Acc& acc, const Unit& u, int wr, int wc, int fr, int fq) const {
        const int b = u.pm >> 8, g = (u.pm >> 1) & 127, chunk0 = (u.pm & 1) * 256 + wr * 64 + fr, col0 = wc * 32 + 8 * fq;
#pragma unroll
        for (int ai = 0; ai < 2; ++ai)
#pragma unroll
            for (int m = 0; m < 4; ++m) { const int chunk = chunk0 + ai * HALF + m * 16;
#pragma unroll
                for (int bj = 0; bj < 2; ++bj) { const int col = col0 + bj * HALF, tt = col >> 4, c0 = col & 15; f32x4 v0 = acc[ai][bj][m][0], v1 = acc[ai][bj][m][1];
#pragma unroll
                    for (int j = 0; j < 4; ++j) { v0[j] = gelu_tanh_e(v0[j]); v1[j] = gelu_tanh_e(v1[j]); }
                    u32x4 w; w.x = cvt_pk_bf16(v0[0], v0[1]); w.y = cvt_pk_bf16(v0[2], v0[3]); w.z = cvt_pk_bf16(v1[0], v1[1]); w.w = cvt_pk_bf16(v1[2], v1[3]);
                    *(u32x4*)(YS + ((size_t)b * 8192 + chunk * 16 + tt) * DM + 16 * g + c0) = w; } }
    }
};
struct PairOrder {
    int pair;
    __device__ bool next(int i, Unit& u) const { if (i >= 2) return false; u.pm = 2 * pair + i; u.pn = pair & 127; return true; }
    __device__ __forceinline__ size_t a_off(const Unit&) const { return 0; }
};
struct EpiRwkv1 {
    static constexpr bool PERM = true, PREP = false;
    bf16* RKV; bf16* LORA;
    __device__ __forceinline__ void operator()(const Acc& acc, const Unit& u, int wr, int wc, int fr, int fq) const {
        const int lane = fq * 16 + fr, sr = lane >> 2, sq = lane & 3;
        const int row0 = u.pm * BM + wr * 64 + sr; const int pn = u.pn;
        bf16* base; int ldc, colt, act;
        if (pn < 24) { base = RKV + (size_t)(pn >> 3) * ((size_t)M * DM); ldc = DM; colt = (pn & 7) * BM; act = 0; }
        else { base = LORA; ldc = 768; colt = (pn - 24) * BM; act = pn - 23; }
        const int col0 = colt + wc * 32 + 8 * sq;
#pragma unroll
        for (int ai = 0; ai < 2; ++ai)
#pragma unroll
            for (int m = 0; m < 4; ++m) { bf16* rowp = base + (size_t)(row0 + ai * HALF + m * 16) * ldc + col0;
#pragma unroll
                for (int bj = 0; bj < 2; ++bj) { f32x4 v0 = acc[ai][bj][m][0], v1 = acc[ai][bj][m][1];
                    if (act == 1) {
#pragma unroll
                        for (int j = 0; j < 4; ++j) { v0[j] = 1.f - 2.f * frcp(__expf(2.f * v0[j]) + 1.f); v1[j] = 1.f - 2.f * frcp(__expf(2.f * v1[j]) + 1.f); } }
                    else if (act == 3) {
#pragma unroll
                        for (int j = 0; j < 4; ++j) { v0[j] = frcp(1.f + __expf(-v0[j])); v1[j] = frcp(1.f + __expf(-v1[j])); } }
                    u32x4 w; w.x = cvt_pk_bf16(v0[0], v0[1]); w.y = cvt_pk_bf16(v0[2], v0[3]); w.z = cvt_pk_bf16(v1[0], v1[1]); w.w = cvt_pk_bf16(v1[2], v1[3]);
                    *(u32x4*)(rowp + bj * HALF) = to_store_layout(w, lane); } }
    }
};
struct EpiSigBf16 {
    static constexpr bool PERM = true, PREP = false;
    bf16* O; int ldc; const float* bias;
    __device__ __forceinline__ void operator()(const Acc& acc, const Unit& u, int wr, int wc, int fr, int fq) const {
        const int lane = fq * 16 + fr, sr = lane >> 2, sq = lane & 3;
        const int row0 = u.pm * BM + wr * 64 + sr, col0 = u.pn * BM + wc * 32 + 8 * sq, cola = u.pn * BM + wc * 32 + 8 * fq;
        f32x4 b0[2], b1[2];
#pragma unroll
        for (int bj = 0; bj < 2; ++bj) { b0[bj] = *(const f32x4*)(bias + cola + bj * HALF); b1[bj] = *(const f32x4*)(bias + cola + bj * HALF + 4); }
#pragma unroll
        for (int ai = 0; ai < 2; ++ai)
#pragma unroll
            for (int m = 0; m < 4; ++m) { bf16* rowp = O + (size_t)(row0 + ai * HALF + m * 16) * ldc + col0;
#pragma unroll
                for (int bj = 0; bj < 2; ++bj) { f32x4 v0 = acc[ai][bj][m][0] + b0[bj], v1 = acc[ai][bj][m][1] + b1[bj];
#pragma unroll
                    for (int j = 0; j < 4; ++j) { v0[j] = frcp(1.f + __expf(-v0[j])); v1[j] = frcp(1.f + __expf(-v1[j])); }
                    u32x4 w; w.x = cvt_pk_bf16(v0[0], v0[1]); w.y = cvt_pk_bf16(v0[2], v0[3]); w.z = cvt_pk_bf16(v1[0], v1[1]); w.w = cvt_pk_bf16(v1[2], v1[3]);
                    *(u32x4*)(rowp + bj * HALF) = to_store_layout(w, lane); } }
    }
};
template <int ACT  > struct EpiBiasF32 {
    static constexpr bool PERM = false, PREP = false;
    float* out; const float* bias;
    __device__ __forceinline__ void operator()(const Acc& acc, const Unit& u, int wr, int wc, int fr, int fq) const {
        const int lane = fq * 16 + fr, sr = lane >> 2, sq = lane & 3;
        const int row0 = u.pm * BM + wr * 64 + sr, col0 = u.pn * BM + wc * 32 + 4 * fq, cols = u.pn * BM + wc * 32 + 4 * sq;
#pragma unroll
        for (int bj = 0; bj < 2; ++bj)
#pragma unroll
            for (int n = 0; n < 2; ++n) { const f32x4 bv = bias ? *(const f32x4*)(bias + col0 + bj * HALF + n * 16) : (f32x4){0.f, 0.f, 0.f, 0.f};
#pragma unroll
                for (int ai = 0; ai < 2; ++ai)
#pragma unroll
                    for (int m = 0; m < 4; ++m) { f32x4 v = acc[ai][bj][m][n] + bv;
                        if (ACT != 0) {
#pragma unroll
                            for (int j = 0; j < 4; ++j) { const float sg = frcp(1.f + __expf(-v[j])); v[j] = (ACT == 1) ? __expf(-0.6065306597126334f * sg) : sg; } }
                        *(u32x4*)(out + (size_t)(row0 + ai * HALF + m * 16) * DM + cols + bj * HALF + n * 16) = to_store_layout(__builtin_bit_cast(u32x4, v), lane); }
                asm volatile("" ::: "memory"); }
    }
};

template <class Epi, class Sched, bool ALIGN_EPI = true>
__device__ __forceinline__ void gemm_phase(LAS unsigned char* lds, const int wave_s, const Gemm g, const Sched& S, const Epi& E_) {
    int wid_ = wave_s; asm volatile("" : "+s"(wid_));
    int lane_; asm volatile("v_mbcnt_lo_u32_b32 %0, -1, 0\n\tv_mbcnt_hi_u32_b32 %0, -1, %0" : "=v"(lane_));
    const int wid = wid_, lane = lane_, tid = wid * 64 + lane, wr = wid >> 2, wc = wid & 3, fr = lane & 15, fq = lane >> 4;
    int K_ = g.K; asm volatile("" : "+s"(K_));
    const int K = K_, nt = K / BK;
    unsigned voffA[2], voffB[2];
#pragma unroll
    for (int i = 0; i < 2; ++i) { int R, C; stage_rc(tid * 16 + i * 8192, R, C); const int Rb = Epi::PERM ? ((R & ~31) + perm32(R & 31)) : R;
        voffA[i] = (unsigned)(R * g.lda + C) * 2u; voffB[i] = (unsigned)(Rb * g.ldb + C) * 2u; }
    const size_t kstep = (size_t)(BK * 2);
    const size_t hstepA = (size_t)HALF * g.lda * 2, hstepB = (size_t)HALF * g.ldb * 2;
    const size_t tstepA = 2 * hstepA, tstepB = 2 * hstepB;
    const unsigned ldsw = (unsigned)wid * 1024u;
    const int aoff = lds_byte(wr * 64 + fr, fq * 8), boff = lds_byte(wc * 32 + fr, fq * 8);
#define PG8_SA(b, h) (((b) * 2 + (h)) * HTB)
#define PG8_SB(b, h) ((4 + (b) * 2 + (h)) * HTB)
#define PG8_STAGE(bufoff, gbase, voff) do { _Pragma("unroll") for (int _i = 0; _i < 2; ++_i) \
        __builtin_amdgcn_global_load_lds((const unsigned*)((const char*)(gbase) + (voff)[_i]), (LAS unsigned*)(lds + (bufoff) + ldsw + _i * 8192), 16, 0, 0); } while (0)
#define PG8_LDA(dst, b, h) do { _Pragma("unroll") for (int m = 0; m < 4; ++m) _Pragma("unroll") for (int k = 0; k < 2; ++k) dst[m][k] = *(const LAS bf16x8*)(lds + PG8_SA(b, h) + aoff + m * 2048 + k * 1024); } while (0)
#define PG8_LDB(dst, b, h) do { _Pragma("unroll") for (int n = 0; n < 2; ++n) _Pragma("unroll") for (int k = 0; k < 2; ++k) dst[n][k] = *(const LAS bf16x8*)(lds + PG8_SB(b, h) + boff + n * 2048 + k * 1024); } while (0)
#define PG8_MMA(ai, bj, At, Bt) do { __builtin_amdgcn_s_setprio(1); _Pragma("unroll") for (int m = 0; m < 4; ++m) _Pragma("unroll") for (int n = 0; n < 2; ++n) _Pragma("unroll") for (int k = 0; k < 2; ++k) \
        acc[ai][bj][m][n] = __builtin_amdgcn_mfma_f32_16x16x32_bf16(Bt[n][k], At[m][k], acc[ai][bj][m][n], 0, 0, 0); __builtin_amdgcn_s_setprio(0); } while (0)
#define PG8_WAIT_V(n) asm volatile("s_waitcnt vmcnt(" #n ")" ::: "memory")
#define PG8_WAIT_L(n) asm volatile("s_waitcnt lgkmcnt(" #n ")" ::: "memory")
#define PG8_BAR __builtin_amdgcn_s_barrier()
#define PG8_SCHED __builtin_amdgcn_sched_barrier(0)
    Unit cur, nxt; int ui = 0;
    if (!S.next(0, cur)) return;
    Epi E = E_;
    if constexpr (Epi::PREP) E.prep(lds, cur.pm, tid);
    Acc acc;
#pragma unroll
    for (int a = 0; a < 2; ++a)
#pragma unroll
        for (int b = 0; b < 2; ++b)
#pragma unroll
            for (int m = 0; m < 4; ++m)
#pragma unroll
                for (int n = 0; n < 2; ++n) acc[a][b][m][n] = (f32x4){0.f, 0.f, 0.f, 0.f};
    bf16x8 At[4][2], B0[2][2], B1[2][2];
    const char* cA = (const char*)g.A + S.a_off(cur) + (size_t)cur.pm * tstepA; const char* cB = (const char*)g.Bt + (size_t)cur.pn * tstepB;
    PG8_STAGE(PG8_SB(0, 0), cB, voffB); PG8_STAGE(PG8_SB(0, 1), cB + hstepB, voffB); PG8_STAGE(PG8_SA(0, 0), cA, voffA); PG8_STAGE(PG8_SA(0, 1), cA + hstepA, voffA);
    if (wr == 1) PG8_BAR;
    PG8_WAIT_V(2); PG8_BAR;
    PG8_STAGE(PG8_SB(1, 0), cB + kstep, voffB); PG8_STAGE(PG8_SA(1, 0), cA + kstep, voffA); PG8_STAGE(PG8_SB(1, 1), cB + hstepB + kstep, voffB);
    PG8_WAIT_V(6); PG8_BAR;
    for (;;) {
        const bool has_next = S.next(ui + 1, nxt);
        const char* nA = has_next ? (const char*)g.A + S.a_off(nxt) + (size_t)nxt.pm * tstepA : cA; const char* nB = has_next ? (const char*)g.Bt + (size_t)nxt.pn * tstepB : cB;
        for (int t = 0; t < nt; t += 2) {
            const bool last = (t == nt - 2);
            const char* a1 = cA + (size_t)(t + 1) * kstep;
            const char* a2 = last ? nA : cA + (size_t)(t + 2) * kstep; const char* b2 = last ? nB : cB + (size_t)(t + 2) * kstep;
            const char* a3 = a2 + kstep; const char* b3 = b2 + kstep;
            PG8_LDB(B0, 0, 0); PG8_LDB(B1, 0, 1); PG8_SCHED; PG8_LDA(At, 0, 0); PG8_STAGE(PG8_SA(1, 1), a1 + hstepA, voffA);
            PG8_WAIT_V(8); PG8_WAIT_L(0); PG8_BAR; PG8_MMA(0, 0, At, B0); PG8_MMA(0, 1, At, B1); PG8_BAR; PG8_SCHED;
            PG8_LDA(At, 0, 1); PG8_STAGE(PG8_SB(0, 0), b2, voffB); PG8_STAGE(PG8_SB(0, 1), b2 + hstepB, voffB); PG8_STAGE(PG8_SA(0, 0), a2, voffA);
            PG8_WAIT_V(8); PG8_WAIT_L(0); PG8_BAR; PG8_MMA(1, 0, At, B0); PG8_MMA(1, 1, At, B1); PG8_BAR; PG8_SCHED;
            PG8_LDB(B0, 1, 0); PG8_LDB(B1, 1, 1); PG8_SCHED; PG8_LDA(At, 1, 0); PG8_STAGE(PG8_SA(0, 1), a2 + hstepA, voffA);
            PG8_WAIT_V(8); PG8_WAIT_L(0); PG8_BAR; PG8_MMA(0, 0, At, B0); PG8_MMA(0, 1, At, B1); PG8_BAR; PG8_SCHED;
            PG8_LDA(At, 1, 1); PG8_STAGE(PG8_SB(1, 0), b3, voffB); PG8_STAGE(PG8_SB(1, 1), b3 + hstepB, voffB); PG8_STAGE(PG8_SA(1, 0), a3, voffA);
            PG8_WAIT_V(8); PG8_WAIT_L(0); PG8_BAR; PG8_MMA(1, 0, At, B0); PG8_MMA(1, 1, At, B1); PG8_BAR; PG8_SCHED;
        }
        if constexpr (ALIGN_EPI) { if (wr == 0) PG8_BAR; }
        E(acc, cur, wr, wc, fr, fq);
        if (!has_next) break;
#pragma unroll
        for (int a = 0; a < 2; ++a)
#pragma unroll
            for (int b = 0; b < 2; ++b)
#pragma unroll
                for (int m = 0; m < 4; ++m)
#pragma unroll
                    for (int n = 0; n < 2; ++n) acc[a][b][m][n] = (f32x4){0.f, 0.f, 0.f, 0.f};
        cur = nxt; cA = nA; cB = nB; ++ui;
        if constexpr (ALIGN_EPI) { if (wr == 1) PG8_BAR; }
    }
    PG8_WAIT_V(0);
    if constexpr (!ALIGN_EPI) { if (wr == 0) PG8_BAR; }
    PG8_BAR;
#undef PG8_SA
#undef PG8_SB
#undef PG8_STAGE
#undef PG8_LDA
#undef PG8_LDB
#undef PG8_MMA
#undef PG8_WAIT_V
#undef PG8_WAIT_L
#undef PG8_BAR
#undef PG8_SCHED
}
}

constexpr size_t MiB = 1u << 20;
constexpr size_t WS_CTL = 0, CTL_ZERO_BYTES = 2 * MiB;
constexpr size_t WS_W = 2 * MiB;
constexpr size_t WS_XR = 210 * MiB;
constexpr size_t WS_H = 146 * MiB;
constexpr size_t WS_BIG = 274 * MiB;
constexpr size_t WS_END = WS_BIG + 866 * MiB;
constexpr size_t W_QKV = 0, W_AO = 72 * MiB;
constexpr size_t W_SIN = 0, W_SOUT = 8 * MiB, W_SY = 24 * MiB, W_SF = 50 * MiB;
constexpr size_t W_RF = 0, W_R2W = 54 * MiB, W_R2A = 55 * MiB, W_R2G = 56 * MiB, W_RO = 57 * MiB;
constexpr size_t W_M1 = 80 * MiB, W_M2 = 112 * MiB;
constexpr size_t B_QKV = 0, B_LSE = 576 * MiB, B_OG = 580 * MiB;
constexpr size_t B_U = 0, B_XO = 128 * MiB;
constexpr size_t B_RKV = 0, B_LORA = 192 * MiB, B_DEC = 216 * MiB, B_AV = 344 * MiB, B_G = 472 * MiB, B_Y = 216 * MiB, B_X6 = 216 * MiB, B_FR = 536 * MiB;
constexpr size_t B_HID = 0;
constexpr size_t CTL_SSQ = 512 * 1024;
constexpr int CW_BAR = 4096;

constexpr int RING_BYTES = 139264;
constexpr int MISC_OFF = RING_BYTES;
constexpr int LDS_BYTES = RING_BYTES + 256;

#define LDS_WAIT() asm volatile("s_waitcnt lgkmcnt(0)" ::: "memory")
#define VM_WAIT() asm volatile("s_waitcnt vmcnt(0)" ::: "memory")
typedef __bf16 bf16x2_t __attribute__((ext_vector_type(2)));
__device__ __forceinline__ unsigned pk2(float lo, float hi) { const f32x2 v = (f32x2){lo, hi}; const bf16x2_t b = __builtin_convertvector(v, bf16x2_t); return __builtin_bit_cast(unsigned, b); }
__device__ __forceinline__ unsigned f2bf(float f) { return pk2(f, 0.f) & 0xffffu; }
__device__ __forceinline__ float bf_lo(unsigned w) { return __builtin_bit_cast(float, w << 16); }
__device__ __forceinline__ float bf_hi(unsigned w) { return __builtin_bit_cast(float, w & 0xffff0000u); }

#define XB_TMO      128
#define XB_XCNT(j)  (256  + 64 * (j))
#define XB_XSUB(j)  (1280 + 64 * (j))
#define XB_XGEN(j)  (2304 + 64 * (j))
#define XB_TOP      3328
#define XB_TOPGEN   3392
#define XCD_BAR_WORDS 3456
#define XB_SPIN_CAP (1u << 22)
__device__ __forceinline__ unsigned xb_ld(unsigned* p)              { return __hip_atomic_load(p, __ATOMIC_RELAXED, __HIP_MEMORY_SCOPE_AGENT); }
__device__ __forceinline__ unsigned xb_add(unsigned* p, unsigned v) { return __hip_atomic_fetch_add(p, v, __ATOMIC_RELAXED, __HIP_MEMORY_SCOPE_AGENT); }
__device__ __forceinline__ unsigned xb_xcc_id() { return (unsigned)__builtin_amdgcn_s_getreg((3 << 11) | 20) & 0xFu; }
#define XB_SPIN(cond, bar) do { unsigned _sp = 0; while (cond) { __builtin_amdgcn_s_sleep(1); \
    if ((++_sp & 255u) == 0u) { if (xb_ld(&(bar)[XB_TMO])) break; if (_sp > XB_SPIN_CAP) { atomicAdd(&(bar)[XB_TMO], 1u); break; } } } } while (0)
struct XcdBarrier { unsigned* bar; unsigned x; volatile LAS unsigned* st; int wave; };
__device__ __forceinline__ bool xb_leader(int wave) { return wave == 0 && __builtin_amdgcn_mbcnt_hi(~0u, __builtin_amdgcn_mbcnt_lo(~0u, 0u)) == 0u; }
__device__ __forceinline__ XcdBarrier xcd_barrier_post(unsigned* bar, volatile LAS unsigned* st, int wave) {
    XcdBarrier b; b.bar = bar; b.x = xb_xcc_id(); b.st = st; b.wave = wave;
    if (xb_leader(wave)) (void)xb_add(&bar[XB_XCNT(b.x)], 1u);
    return b;
}
__device__ __forceinline__ void xcd_barrier_complete(unsigned* bar, unsigned x, unsigned& nloc, unsigned& nx) {
    const unsigned G = gridDim.x * gridDim.y * gridDim.z;
    unsigned sum, cnt, mine, sp = 0u;
    for (;;) {
        sum = 0u; cnt = 0u; mine = 0u;
#pragma unroll
        for (unsigned j = 0; j < 16; ++j) { const unsigned c = xb_ld(&bar[XB_XCNT(j)]); sum += c; cnt += (c > 0u) ? 1u : 0u; mine = (j == x) ? c : mine; }
        if (sum == G) break;
        __builtin_amdgcn_s_sleep(1);
        if ((++sp & 255u) == 0u) { if (xb_ld(&bar[XB_TMO])) break; if (sp > XB_SPIN_CAP) { atomicAdd(&bar[XB_TMO], 1u); break; } }
    }
    nloc = mine > 0u ? mine : 1u; nx = cnt > 0u ? cnt : 1u;
}
__device__ __forceinline__ void xcd_barrier(const XcdBarrier& b) {
    asm volatile("s_waitcnt vmcnt(0)" ::: "memory");
    __syncthreads();
    if (xb_leader(b.wave)) {
        unsigned* bar = b.bar;
        __builtin_amdgcn_s_waitcnt(0);
        unsigned nloc = b.st[0], nx = b.st[1];
        if (nloc == 0u) { xcd_barrier_complete(bar, b.x, nloc, nx); b.st[0] = nloc; b.st[1] = nx; }
        const unsigned old = xb_add(&bar[XB_XSUB(b.x)], 1u);
        const unsigned gen = old / nloc;
        if (old + 1u == (gen + 1u) * nloc) {
            __builtin_amdgcn_fence(__ATOMIC_RELEASE, "agent");
            asm volatile("s_waitcnt vmcnt(0)" ::: "memory");
            const unsigned og = xb_add(&bar[XB_TOP], 1u);
            const unsigned tg = og / nx;
            if (og + 1u == (tg + 1u) * nx) xb_add(&bar[XB_TOPGEN], 1u);
            else XB_SPIN(xb_ld(&bar[XB_TOPGEN]) == tg, bar);
            __builtin_amdgcn_fence(__ATOMIC_ACQUIRE, "agent");
            xb_add(&bar[XB_XGEN(b.x)], 1u);
            asm volatile("s_waitcnt vmcnt(0)" ::: "memory");
        } else {
            XB_SPIN(xb_ld(&bar[XB_XGEN(b.x)]) == gen, bar);
            __builtin_amdgcn_fence(__ATOMIC_ACQUIRE, "agent");
            asm volatile("s_waitcnt vmcnt(0)" ::: "memory");
        }
    }
    __syncthreads();
}

struct Frame {
    LAS unsigned char* lds;
    int tid, lane, wave, G, gw, NGW;
};
__device__ __forceinline__ Frame phase_frame(const Frame& F0) {
    Frame F = F0; int wv = F0.wave; asm volatile("" : "+s"(wv)); F.wave = wv; int ln; asm volatile("v_mbcnt_lo_u32_b32 %0, -1, 0\n\tv_mbcnt_hi_u32_b32 %0, -1, %0" : "=v"(ln)); F.lane = ln; F.tid = wv * 64 + F.lane;
    F.gw = blockIdx.x * NWAVES + F.wave; return F;
}
template <class T> __device__ __forceinline__ T ldnt(const T* p) { return __builtin_nontemporal_load(p); }
__device__ __forceinline__ float wave_sum(float v) {
#pragma unroll
    for (int o = 1; o < 64; o <<= 1) v += __shfl_xor(v, o);
    return v;
}

__device__ __forceinline__ void cvt_mat(const Frame& F0, const float* src, int ld_src, int Ksrc, int Nsrc, int Kpad, int Npad,
                                        bf16* dst, int ld_dst, int drow0, int dcol0, const float* scale, int smode, int glu) {
    const Frame F = phase_frame(F0);
    LAS float* scr = (LAS float*)(F.lds + F.wave * 8704);
    const int nblk = Npad / 32, nitems = (Kpad / 64) * nblk, lane = F.lane;
    for (int it = F.gw; it < nitems; it += F.NGW) {
        const int kb = it / nblk, nb = it - kb * nblk, k0 = 64 * kb, n0 = 32 * nb;
        float vals[32];
        const int n = n0 + (lane & 31);
        if (k0 + 64 <= Ksrc && n0 + 32 <= Nsrc) {
            const float* sp = src + (size_t)(k0 + (lane >> 5)) * ld_src + n;
#pragma unroll
            for (int i = 0; i < 32; ++i) vals[i] = ldnt(sp + (size_t)(2 * i) * ld_src);
            if (smode) {
#pragma unroll
                for (int i = 0; i < 32; ++i) { const float s = scale[k0 + 2 * i + (lane >> 5)]; vals[i] *= (smode == 1) ? s : (1.f - s); } }
        } else {
#pragma unroll
            for (int i = 0; i < 32; ++i) { const int k = k0 + 2 * i + (lane >> 5); float v = 0.f;
                if (k < Ksrc && n < Nsrc) { v = src[(size_t)k * ld_src + n]; if (smode == 1) v *= scale[k]; else if (smode == 2) v *= (1.f - scale[k]); }
                vals[i] = v; }
        }
#pragma unroll
        for (int i = 0; i < 32; ++i) scr[(2 * i + (lane >> 5)) * 33 + (lane & 31)] = vals[i];
        LDS_WAIT(); asm volatile("" ::: "memory");
        const int c = lane & 7;
#pragma unroll
        for (int j = 0; j < 4; ++j) { const int n = (lane >> 3) + 8 * j; const LAS float* s = scr + (8 * c) * 33 + n;
            u32x4 o; o.x = pk2(s[0 * 33], s[1 * 33]); o.y = pk2(s[2 * 33], s[3 * 33]); o.z = pk2(s[4 * 33], s[5 * 33]); o.w = pk2(s[6 * 33], s[7 * 33]);
            const int nn = n0 + n; int drow;
            if (glu) drow = (nn < 2048) ? (256 * (nn >> 7) + (nn & 127)) : (256 * ((nn - 2048) >> 7) + 128 + ((nn - 2048) & 127)); else drow = drow0 + nn;
            *(u32x4*)(dst + (size_t)drow * ld_dst + dcol0 + k0 + 8 * c) = o; }
        LDS_WAIT(); asm volatile("" ::: "memory");
    }
}

__device__ __forceinline__ void load_row(const void* x, bool is_bf16, int m, int lane, f32x4 (&v)[8]) {
    if (!is_bf16) { const f32x4* xr = (const f32x4*)((const float*)x + (size_t)m * DM) + lane;
#pragma unroll
        for (int j = 0; j < 8; ++j) v[j] = xr[64 * j]; }
    else { const u32x2* xr = (const u32x2*)((const bf16*)x + (size_t)m * DM) + lane;
#pragma unroll
        for (int j = 0; j < 8; ++j) { const u32x2 w = xr[64 * j]; v[j] = (f32x4){bf_lo(w.x), bf_hi(w.x), bf_lo(w.y), bf_hi(w.y)}; } }
}
__device__ __forceinline__ void norm_rows_rwkv(const Frame& F0, const bf16* x, const float* gain, const float* mu, bf16* X6) {
    const Frame F = phase_frame(F0);
    for (int r0 = F.gw * 8; r0 < M; r0 += F.NGW * 8) {
        f32x4 hp[8], v[8];
        const f32x4* gr = (const f32x4*)gain + F.lane;
        if ((r0 & (SEQ - 1)) == 0) {
#pragma unroll
            for (int j = 0; j < 8; ++j) hp[j] = (f32x4){0.f, 0.f, 0.f, 0.f};
        } else { float s = 0.f; load_row(x, true, r0 - 1, F.lane, hp);
#pragma unroll
            for (int j = 0; j < 8; ++j) s += (hp[j].x * hp[j].x + hp[j].y * hp[j].y) + (hp[j].z * hp[j].z + hp[j].w * hp[j].w);
            const float rstd = 1.f / sqrtf(wave_sum(s) * (1.f / DM) + NORM_EPS);
#pragma unroll
            for (int j = 0; j < 8; ++j) hp[j] = hp[j] * rstd * gr[64 * j]; }
        for (int rr = 0; rr < 8; ++rr) { const int m = r0 + rr;
            float s = 0.f; load_row(x, true, m, F.lane, v);
#pragma unroll
            for (int j = 0; j < 8; ++j) s += (v[j].x * v[j].x + v[j].y * v[j].y) + (v[j].z * v[j].z + v[j].w * v[j].w);
            const float rstd = 1.f / sqrtf(wave_sum(s) * (1.f / DM) + NORM_EPS);
#pragma unroll
            for (int j = 0; j < 8; ++j) v[j] = v[j] * rstd * gr[64 * j];
            for (int q = 0; q < 6; ++q) { const f32x4* mr = (const f32x4*)(mu + (size_t)q * DM) + F.lane; u32x2* o = (u32x2*)(X6 + ((size_t)q * M + m) * DM) + F.lane;
#pragma unroll
                for (int j = 0; j < 8; ++j) { const f32x4 mm = mr[64 * j]; const f32x4 xm = v[j] + (hp[j] - v[j]) * mm; u32x2 w; w.x = pk2(xm.x, xm.y); w.y = pk2(xm.z, xm.w); o[64 * j] = w; } }
#pragma unroll
            for (int j = 0; j < 8; ++j) hp[j] = v[j]; }
    }
}
__device__ __forceinline__ void norm_rows(const Frame& F0, const void* x, bool x_bf16, const float* gain, bf16* H, float* outf, int mode) {
    const Frame F = phase_frame(F0);
    for (int m = F.gw; m < M; m += F.NGW) {
        f32x4 v[8]; float s = 0.f; load_row(x, x_bf16, m, F.lane, v);
#pragma unroll
        for (int j = 0; j < 8; ++j) s += (v[j].x * v[j].x + v[j].y * v[j].y) + (v[j].z * v[j].z + v[j].w * v[j].w);
        const float rstd = 1.f / sqrtf(wave_sum(s) * (1.f / DM) + NORM_EPS);
        const f32x4* gr = (const f32x4*)gain + F.lane;
#pragma unroll
        for (int j = 0; j < 8; ++j) { const f32x4 g = gr[64 * j]; v[j] = v[j] * rstd * g; }
        if (mode == 2) { f32x4* o = (f32x4*)(outf + (size_t)m * DM) + F.lane;
#pragma unroll
            for (int j = 0; j < 8; ++j) o[64 * j] = v[j]; }
        else if (mode == 0) { u32x2* o = (u32x2*)(H + (size_t)m * DM) + F.lane;
#pragma unroll
            for (int j = 0; j < 8; ++j) { u32x2 w; w.x = pk2(v[j].x, v[j].y); w.y = pk2(v[j].z, v[j].w); o[64 * j] = w; } }
        else { }
    }
}

typedef short v4i16_t __attribute__((ext_vector_type(4)));
__device__ __forceinline__ unsigned off_b(unsigned row, unsigned ch) { return 256u * row + 16u * (ch ^ (((row & 3u) << 2) | ((row >> 2) & 3u))); }
constexpr int ATT_K_OFF = 0, ATT_V_OFF = 65536;
struct AttnUnit { int g, dsh, blk, hd, fresh; size_t rowbase; };
__device__ __forceinline__ AttnUnit attn_decode(int L, int i) {
    AttnUnit a; int chain;
    if (i < 8) { a.g = 0; chain = L >> 3; a.blk = 8 * (L & 7) + i; a.fresh = (i == 0); }
    else if (i < 16) { a.g = 1; chain = L >> 1; a.blk = 8 * (L & 1) + (i - 8); a.fresh = (i == 8); }
    else { a.g = 2; chain = 2 * L + ((i - 16) >> 2); a.blk = (i - 16) & 3; a.fresh = (a.blk == 0); }
    a.dsh = 2 * a.g; a.hd = chain & 15; const int r = (chain >> 4) & ((1 << a.dsh) - 1), b = chain >> (4 + a.dsh);
    a.rowbase = (size_t)b * SEQ + r; return a;
}
__device__ __forceinline__ void attn_phase(const Frame& F0, const bf16* QKV, float* LSE, bf16* OG) {
    const Frame F = phase_frame(F0);
    LAS unsigned char* lds = F.lds;
    const int tid = F.tid, lane = F.lane, w = F.wave, q16 = lane & 15, grp = lane >> 4, qq = (lane & 15) >> 2, pp = lane & 3;
    u32x4 pk[2][4], pv[2][4]; bf16x8 pq[2][4];
    auto fetch_kv = [&](const AttnUnit& a, const int h) {
        const bf16* Kg = QKV + a.g * 6144 + a.hd * 128 + 2048; const bf16* Vg = Kg + 2048;
#pragma unroll
        for (int i = 0; i < 4; ++i) { const int row = (tid >> 4) + 32 * i, ch = tid & 15;
            const size_t mrow = a.rowbase + ((size_t)(128 * a.blk + row) << a.dsh); pk[h][i] = ldnt((const u32x4*)(Kg + mrow * NQKV + ch * 8)); pv[h][i] = ldnt((const u32x4*)(Vg + mrow * NQKV + ch * 8)); }
    };
    auto fetch_q = [&](const AttnUnit& a, const int h) {
        const bf16* Qg = QKV + a.g * 6144 + a.hd * 128;
        const size_t mq = a.rowbase + ((size_t)(128 * a.blk + 16 * w + q16) << a.dsh);
#pragma unroll
        for (int s = 0; s < 4; ++s) pq[h][s] = ldnt((const bf16x8*)(Qg + mq * NQKV + 32 * s + 8 * grp));
    };
    int par = 0;
    for (int L = blockIdx.x; L < 256; L += gridDim.x) {
        fetch_kv(attn_decode(L, 0), 0); fetch_q(attn_decode(L, 0), 0); fetch_kv(attn_decode(L, 1), 1); fetch_q(attn_decode(L, 1), 1);
        for (int u2 = 0; u2 < 24; u2 += 2) {
#pragma unroll
          for (int h = 0; h < 2; ++h) { const int ui = u2 + h;
            const AttnUnit a = attn_decode(L, ui); const int g = a.g, dsh = a.dsh, d = 1 << dsh, blk = a.blk, hd = a.hd;
            bf16* Og = OG + (size_t)g * M * DM + hd * 128;
#pragma unroll
            for (int i = 0; i < 4; ++i) { const int row = (tid >> 4) + 32 * i, ch = tid & 15;
                *(LAS u32x4*)(lds + ATT_K_OFF + 32768 * par + off_b(row, ch)) = pk[h][i]; *(LAS u32x4*)(lds + ATT_V_OFF + 32768 * par + off_b(row, ch)) = pv[h][i];
                if (a.fresh) {
                    u32x4 k2 = (u32x4){0u, 0u, 0u, 0u}, v2 = k2;
                    if (blk > 0) { const bf16* Kg = QKV + g * 6144 + hd * 128 + 2048; const size_t mrow2 = a.rowbase + ((size_t)(128 * (blk - 1) + row) << dsh); k2 = ldnt((const u32x4*)(Kg + mrow2 * NQKV + ch * 8)); v2 = ldnt((const u32x4*)(Kg + 2048 + mrow2 * NQKV + ch * 8)); }
                    *(LAS u32x4*)(lds + ATT_K_OFF + 32768 * (par ^ 1) + off_b(row, ch)) = k2; *(LAS u32x4*)(lds + ATT_V_OFF + 32768 * (par ^ 1) + off_b(row, ch)) = v2; } }
            const unsigned mq = (unsigned)a.rowbase + ((unsigned)(128 * blk + 16 * w + q16) << dsh);
            __syncthreads();
            if (ui + 2 < 24) fetch_kv(attn_decode(L, ui + 2), h);
            int lq_ = lane; asm volatile("" : "+v"(lq_));
            const int q16_ = lq_ & 15, grp_ = lq_ >> 4, qq_ = (lq_ & 15) >> 2, pp_ = lq_ & 3;
            const unsigned kswz = ((q16_ & 3) << 2) | ((q16_ >> 2) & 3), vswz = (qq_ << 2) | grp_;
            unsigned kaddr[4];
#pragma unroll
            for (int s = 0; s < 4; ++s) kaddr[s] = ATT_K_OFF + 256u * q16_ + 16u * ((4 * s + grp_) ^ kswz);
            f32x4 sacc[9];
#pragma unroll
            for (int T = 0; T < 9; ++T) { sacc[T] = (f32x4){0.f, 0.f, 0.f, 0.f}; const int Tw = w + T; const unsigned toff = 4096u * (Tw & 7) + 32768u * ((Tw >> 3) ? par : (par ^ 1));
#pragma unroll
                for (int s = 0; s < 4; ++s) { const bf16x8 kf = *(const LAS bf16x8*)(lds + kaddr[s] + toff);
                    sacc[T] = __builtin_amdgcn_mfma_f32_16x16x32_bf16(kf, pq[h][s], sacc[T], 0, 0, 0); } }
            asm volatile("" ::: "memory");
            if (ui + 2 < 24) fetch_q(attn_decode(L, ui + 2), h);
            const float slope = exp2f(-8.f * (float)(g * 16 + hd + 1) / 48.f);
            const float c1 = 0.08838834764831845f * 1.4426950408889634f, c2 = slope * (float)d * 1.4426950408889634f;
            const float NEG = -__builtin_inff();
            float mx = NEG;
#pragma unroll
            for (int T = 0; T < 9; ++T)
#pragma unroll
                for (int i = 0; i < 4; ++i) { const int wj = 16 * (w + T) + 4 * grp + i, dist = 128 + 16 * w + q16 - wj;
                    const bool valid = (dist >= 0) && (dist <= 128) && (blk > 0 || wj >= 128);
                    const float s2 = valid ? (sacc[T][i] * c1 - c2 * (float)dist) : NEG; sacc[T][i] = s2; mx = fmaxf(mx, s2); }
            mx = fmaxf(mx, __shfl_xor(mx, 16)); mx = fmaxf(mx, __shfl_xor(mx, 32));
            float lsum = 0.f;
#pragma unroll
            for (int T = 0; T < 9; ++T)
#pragma unroll
                for (int i = 0; i < 4; ++i) { const float p = __builtin_amdgcn_exp2f(sacc[T][i] - mx); sacc[T][i] = p; lsum += p; }
            lsum += __shfl_xor(lsum, 16); lsum += __shfl_xor(lsum, 32);
            bf16x8 pf[5];
#pragma unroll
            for (int ks = 0; ks < 5; ++ks) { u32x4 pw;
                pw.x = pg8::cvt_pk_bf16(sacc[2 * ks][0], sacc[2 * ks][1]); pw.y = pg8::cvt_pk_bf16(sacc[2 * ks][2], sacc[2 * ks][3]);
                if (ks < 4) { pw.z = pg8::cvt_pk_bf16(sacc[2 * ks + 1][0], sacc[2 * ks + 1][1]); pw.w = pg8::cvt_pk_bf16(sacc[2 * ks + 1][2], sacc[2 * ks + 1][3]); } else { pw.z = 0u; pw.w = 0u; }
                pf[ks] = __builtin_bit_cast(bf16x8, pw); }
            const float inv = 1.f / lsum;
            unsigned vaddr[8];
#pragma unroll
            for (int c = 0; c < 8; ++c) vaddr[c] = ATT_V_OFF + 256u * (4 * grp_ + qq_) + 16u * ((2 * c + (pp_ >> 1)) ^ vswz) + 8u * (pp_ & 1);
            unsigned voff[10];
#pragma unroll
            for (int j = 0; j < 10; ++j) { const int Tw = w + j; voff[j] = 4096u * (Tw & 7) + 32768u * (((Tw >> 3) & 1) ? par : (par ^ 1)); if (Tw >= 16) voff[j] = 32768u * par; }
#pragma unroll
            for (int c = 0; c < 8; ++c) { f32x4 o = (f32x4){0.f, 0.f, 0.f, 0.f};
#pragma unroll
                for (int ks = 0; ks < 5; ++ks) {
                    const s16x4 v0 = __builtin_bit_cast(s16x4, __builtin_amdgcn_ds_read_tr16_b64_v4i16((LAS v4i16_t*)(lds + vaddr[c] + voff[2 * ks])));
                    const s16x4 v1 = (ks == 4) ? (s16x4){0, 0, 0, 0}
                                               : __builtin_bit_cast(s16x4, __builtin_amdgcn_ds_read_tr16_b64_v4i16((LAS v4i16_t*)(lds + vaddr[c] + voff[2 * ks + 1])));
                    bf16x8 vf; vf[0] = v0[0]; vf[1] = v0[1]; vf[2] = v0[2]; vf[3] = v0[3]; vf[4] = v1[0]; vf[5] = v1[1]; vf[6] = v1[2]; vf[7] = v1[3];
                    o = __builtin_amdgcn_mfma_f32_16x16x32_bf16(vf, pf[ks], o, 0, 0, 0); }
                u32x2 ow; ow.x = pg8::cvt_pk_bf16(o[0] * inv, o[1] * inv); ow.y = pg8::cvt_pk_bf16(o[2] * inv, o[3] * inv);
                *(u32x2*)(Og + (mq * (unsigned)DM + 16u * c + 4u * grp)) = ow; }
            if (grp == 0) (LSE + (size_t)g * M * 16 + hd)[mq * 16u] = (mx + log2f(lsum)) * 0.6931471805599453f;
            __syncthreads();
            par ^= 1;
          }
        }
    }
}
__device__ __forceinline__ void attn_merge_phase(const Frame& F0, const bf16* OG, const float* LSE, bf16* O) {
    const Frame F = phase_frame(F0);
    const int gt = blockIdx.x * 512 + F.tid, NT = F.G * 512;
    for (int idx = gt; idx < M * 256; idx += NT) {
        const int m = idx >> 8, ch = idx & 255, hd = ch >> 4;
        const float l0 = LSE[((size_t)0 * M + m) * 16 + hd], l1 = LSE[((size_t)1 * M + m) * 16 + hd], l2 = LSE[((size_t)2 * M + m) * 16 + hd];
        const float mx = fmaxf(l0, fmaxf(l1, l2)); float w0 = __expf(l0 - mx), w1 = __expf(l1 - mx), w2 = __expf(l2 - mx); const float inv = frcp(w0 + w1 + w2); w0 *= inv; w1 *= inv; w2 *= inv;
        const bf16* base = OG + (size_t)m * DM + ch * 8;
        const u32x4 a = ldnt((const u32x4*)(base)), b = ldnt((const u32x4*)(base + (size_t)M * DM)), c = ldnt((const u32x4*)(base + 2 * (size_t)M * DM));
        u32x4 o;
#pragma unroll
        for (int j = 0; j < 4; ++j) { const float lo = w0 * bf_lo(a[j]) + w1 * bf_lo(b[j]) + w2 * bf_lo(c[j]), hi = w0 * bf_hi(a[j]) + w1 * bf_hi(b[j]) + w2 * bf_hi(c[j]); o[j] = pk2(lo, hi); }
        *(u32x4*)(O + (size_t)m * DM + ch * 8) = o;
    }
}

__device__ __forceinline__ void s5_zoh(float ldt, float are, float aim, float& abr, float& abi, float& cr, float& ci) {
    const float dt = expf(ldt), mag = expf(dt * are); float sn, cs; sincosf(dt * aim, &sn, &cs);
    abr = mag * cs; abi = mag * sn; const float den = are * are + aim * aim, zr = abr - 1.f;
    cr = (zr * are + abi * aim) / den; ci = (abi * are - zr * aim) / den;
}
__device__ __forceinline__ void s5_precompute(const Frame& F0, const float* log_dt, const float* a_re, const float* a_im, const float* b_re, const float* b_im,
                                              const float* c_re, const float* c_im, const float* dsk, bf16* Wy, bf16* Wf) {
    const Frame F = phase_frame(F0); const int tid = F.tid;
    LAS float* pwr = (LAS float*)F.lds; LAS float* pwi = pwr + 17 * 64; LAS float* bbr = pwi + 17 * 64; LAS float* bbi = bbr + 1024; LAS float* cr_ = bbi + 1024; LAS float* ci_ = cr_ + 1024;
    LAS float* Kl = ci_ + 1024; LAS float* dl = Kl + 4096;
    for (int gi = blockIdx.x; gi < 256; gi += gridDim.x) { const int g = gi & 127, hf = gi >> 7;
        __syncthreads();
        if (tid < 64) { const int p = tid; float abr, abi, cr, ci; s5_zoh(log_dt[g], a_re[g * 64 + p], a_im[g * 64 + p], abr, abi, cr, ci);
            float pr = 1.f, pi = 0.f;
            for (int j = 0; j <= 16; ++j) { pwr[j * 64 + p] = pr; pwi[j * 64 + p] = pi; const float nr = pr * abr - pi * abi, ni = pr * abi + pi * abr; pr = nr; pi = ni; }
            for (int c = 0; c < 16; ++c) { const float br = b_re[(size_t)(g * 64 + p) * 16 + c], bi = b_im[(size_t)(g * 64 + p) * 16 + c]; bbr[p * 16 + c] = cr * br - ci * bi; bbi[p * 16 + c] = cr * bi + ci * br; } }
        for (int i = tid; i < 1024; i += 512) { cr_[i] = c_re[(size_t)g * 1024 + i]; ci_[i] = c_im[(size_t)g * 1024 + i]; }
        if (tid < 16) dl[tid] = dsk[g * 16 + tid];
        __syncthreads();
        for (int i2 = tid; i2 < 2048; i2 += 512) { const int j = i2 >> 7, c = 8 * hf + ((i2 >> 4) & 7), c2 = i2 & 15, idx = (j * 16 + c) * 16 + c2; float s = 0.f;
            for (int p = 0; p < 64; ++p) { const float car = cr_[c * 64 + p] * pwr[j * 64 + p] - ci_[c * 64 + p] * pwi[j * 64 + p], cai = cr_[c * 64 + p] * pwi[j * 64 + p] + ci_[c * 64 + p] * pwr[j * 64 + p];
                s += car * bbr[p * 16 + c2] - cai * bbi[p * 16 + c2]; }
            Kl[idx] = s; }
        __syncthreads();
        for (int i2 = tid; i2 < 128 * 48; i2 += 512) { const int r2 = i2 / 48, ch = i2 - r2 * 48, t = r2 >> 3, c = 8 * hf + (r2 & 7), row = t * 16 + c; float v[8];
            if (ch < 32) { const int s = ch >> 1, c2b = (ch & 1) * 8;
#pragma unroll
                for (int e = 0; e < 8; ++e) v[e] = (s <= t) ? (Kl[(((t - s) * 16 + c) * 16) + c2b + e] + ((s == t && c2b + e == c) ? dl[c] : 0.f)) : 0.f;
            } else { const int q0 = (ch - 32) * 8;
#pragma unroll
                for (int e = 0; e < 8; ++e) { const int q = q0 + e, p = q & 63; const float a = cr_[c * 64 + p], bq = ci_[c * 64 + p], wr_ = pwr[(t + 1) * 64 + p], wi_ = pwi[(t + 1) * 64 + p];
                    v[e] = (q < 64) ? (a * wr_ - bq * wi_) : -(a * wi_ + bq * wr_); } }
            u32x4 o; o.x = pk2(v[0], v[1]); o.y = pk2(v[2], v[3]); o.z = pk2(v[4], v[5]); o.w = pk2(v[6], v[7]);
            *(u32x4*)(Wy + ((size_t)g * 256 + row) * 384 + 8 * ch) = o; }
        for (int i2 = tid; i2 < 128 * 32; i2 += 512) { const int row = 128 * hf + (i2 >> 5), ch = i2 & 31, s = ch >> 1, c2b = (ch & 1) * 8, p = row & 63; float v[8];
#pragma unroll
            for (int e = 0; e < 8; ++e) { const float wr_ = pwr[(15 - s) * 64 + p], wi_ = pwi[(15 - s) * 64 + p], br = bbr[p * 16 + c2b + e], bi = bbi[p * 16 + c2b + e];
                v[e] = (row < 64) ? (wr_ * br - wi_ * bi) : ((row < 128) ? (wr_ * bi + wi_ * br) : 0.f); }
            u32x4 o; o.x = pk2(v[0], v[1]); o.y = pk2(v[2], v[3]); o.z = pk2(v[4], v[5]); o.w = pk2(v[6], v[7]);
            *(u32x4*)(Wf + ((size_t)g * 256 + row) * 256 + 8 * ch) = o; }
    }
    __syncthreads();
}
__device__ __forceinline__ void s5_chunk_scan(const Frame& F, int pair, const float* Xout, bf16* U16, const float* log_dt, const float* a_re, const float* a_im) {
    const int g = pair & 127, p = F.lane, w = F.wave; float qr, qi, c0_, c1_; s5_zoh(log_dt[g], a_re[g * 64 + p], a_im[g * 64 + p], qr, qi, c0_, c1_);
#pragma unroll
    for (int i = 0; i < 4; ++i) { const float nr = qr * qr - qi * qi, ni = 2.f * qr * qi; qr = nr; qi = ni; }
    float Pr = qr, Pi = qi;
#pragma unroll
    for (int i = 0; i < 6; ++i) { const float nr = Pr * Pr - Pi * Pi, ni = 2.f * Pr * Pi; Pr = nr; Pi = ni; }
    const float* xo = Xout + ((size_t)pair * 512 + 64 * w) * 128 + p; bf16* ur = U16 + ((size_t)pair * 512 + 64 * w) * 512 + 256 + p;
    float er[32], ei[32]; const float* xo2 = xo;
    float lr = 0.f, li = 0.f;
#pragma unroll 1
    for (int hb = 0; hb < 2; ++hb) {
#pragma unroll
        for (int k = 0; k < 32; ++k) { er[k] = xo[0]; ei[k] = xo[64]; xo += 128; asm volatile("" : "+v"(xo)); }
#pragma unroll
        for (int k = 0; k < 32; ++k) { const float nr = qr * lr - qi * li + er[k], ni = qr * li + qi * lr + ei[k]; lr = nr; li = ni; } }
    LAS float* seg = (LAS float*)F.lds;
    seg[(w * 2 + 0) * 64 + p] = lr; seg[(w * 2 + 1) * 64 + p] = li;
    __syncthreads();
    float xr = 0.f, xi = 0.f;
    for (int v = 0; v < w; ++v) { const float sr = seg[(v * 2 + 0) * 64 + p], si = seg[(v * 2 + 1) * 64 + p]; const float nr = Pr * xr - Pi * xi + sr, ni = Pr * xi + Pi * xr + si; xr = nr; xi = ni; }
    xo = xo2;
#pragma unroll 1
    for (int hb = 0; hb < 2; ++hb) {
#pragma unroll
        for (int k = 0; k < 32; ++k) { er[k] = xo[0]; ei[k] = xo[64]; xo += 128; asm volatile("" : "+v"(xo)); }
#pragma unroll
        for (int k = 0; k < 32; ++k) { ur[0] = (bf16)f2bf(xr); ur[64] = (bf16)f2bf(xi); ur += 512; asm volatile("" : "+v"(ur));
            const float nr = qr * xr - qi * xi + er[k], ni = qr * xi + qi * xr + ei[k]; xr = nr; xi = ni; } }
    __syncthreads();
}

__device__ __forceinline__ float sigmoidf_(float z) { return 1.f / (1.f + __expf(-z)); }
__device__ __forceinline__ float rwkv_decay(float z) { return __expf(-0.6065306597126334f / (1.f + __expf(-z))); }
constexpr int RW_TC = 32, RW_BUF = 5 * RW_TC * 64 * 4 + RW_TC * 16 * 4;
constexpr int RW_Y_OFF = 2 * RW_BUF;
__device__ __forceinline__ float row16_sum(float x) {
    x += __builtin_bit_cast(float, __builtin_amdgcn_update_dpp(0, __builtin_bit_cast(int, x), 0x128, 0xf, 0xf, false));
    x += __builtin_bit_cast(float, __builtin_amdgcn_update_dpp(0, __builtin_bit_cast(int, x), 0x124, 0xf, 0xf, false));
    x += __builtin_bit_cast(float, __builtin_amdgcn_update_dpp(0, __builtin_bit_cast(int, x), 0x122, 0xf, 0xf, false));
    x += __builtin_bit_cast(float, __builtin_amdgcn_update_dpp(0, __builtin_bit_cast(int, x), 0x121, 0xf, 0xf, false));
    return x;
}
__device__ __forceinline__ f32x2 pk_fma(f32x2 a, f32x2 b, f32x2 c) { return __builtin_elementwise_fma(a, b, c); }
#define RW_BAR() do { asm volatile("s_waitcnt lgkmcnt(0)" ::: "memory"); __builtin_amdgcn_s_barrier(); asm volatile("" ::: "memory"); } while (0)
__device__ __forceinline__ void rwkv_scan_phase(const Frame& F0, const bf16* RKV, const float* DEC, const float* AV, float* Y, const float* k_k, const float* k_a) {
    const Frame F = phase_frame(F0);
    const int tid = F.tid, lane = F.lane, w = F.wave;
    const bf16* Rb = RKV; const bf16* Kb = RKV + (size_t)M * DM; const bf16* Vb = RKV + 2 * (size_t)M * DM;
    constexpr int NCH = SEQ / RW_TC;
    for (int unit = blockIdx.x; unit < 256; unit += gridDim.x) {
        const int b = unit >> 7, hh = (unit >> 2) & 31, rq = unit & 3;
        const size_t m0 = (size_t)b * SEQ; const int colh = hh * 64;
        const bool scanner = w < 4;
        const int pt = (tid - 256) >> 3, pc8 = (tid - 256) & 7;
        f32x4 kkc0, kkc1, kac0, kac1;
        if (!scanner) { kkc0 = *(const f32x4*)(k_k + colh + 8 * pc8); kkc1 = *(const f32x4*)(k_k + colh + 8 * pc8 + 4); kac0 = *(const f32x4*)(k_a + colh + 8 * pc8); kac1 = *(const f32x4*)(k_a + colh + 8 * pc8 + 4); }
        const int srow = 4 * w + (lane >> 4), scq = lane & 15;
        f32x2 s01 = (f32x2){0.f, 0.f}, s23 = (f32x2){0.f, 0.f};
        u32x4 pkw, prw; f32x4 pd0, pd1, pa0, pa1; unsigned pvw;
        auto issue = [&](int ch) {
            const size_t m = m0 + (size_t)ch * RW_TC + pt; const int col = colh + 8 * pc8;
            pkw = *(const u32x4*)(Kb + m * DM + col); prw = *(const u32x4*)(Rb + m * DM + col);
            pd0 = *(const f32x4*)(DEC + m * DM + col); pd1 = *(const f32x4*)(DEC + m * DM + col + 4); pa0 = *(const f32x4*)(AV + m * DM + col); pa1 = *(const f32x4*)(AV + m * DM + col + 4);
            pvw = *(const unsigned*)(Vb + m * DM + colh + rq * 16 + 2 * pc8);
        };
        auto process = [&](int bi) {
            LAS float* base = (LAS float*)(F.lds + bi * RW_BUF);
            f32x4 d0 = pd0, d1 = pd1, a0 = pa0, a1 = pa1;
#pragma unroll
            for (int j = 0; j < 4; ++j) { }
            float kf[8], rf[8], kk[8], af[8], kkc[8], kac[8];
#pragma unroll
            for (int j = 0; j < 4; ++j) { kf[2 * j] = bf_lo(pkw[j]); kf[2 * j + 1] = bf_hi(pkw[j]); rf[2 * j] = bf_lo(prw[j]); rf[2 * j + 1] = bf_hi(prw[j]); af[j] = a0[j]; af[4 + j] = a1[j];
                kkc[j] = kkc0[j]; kkc[4 + j] = kkc1[j]; kac[j] = kac0[j]; kac[4 + j] = kac1[j]; }
            float ss = 0.f;
#pragma unroll
            for (int j = 0; j < 8; ++j) { kk[j] = kf[j] * kkc[j]; ss += kk[j] * kk[j]; }
            ss += __shfl_xor(ss, 1); ss += __shfl_xor(ss, 2); ss += __shfl_xor(ss, 4);
            const float rn = 1.f / fmaxf(sqrtf(ss), 1e-12f);
            f32x4 A0, A1, B0, B1, K0, K1, R0, R1;
#pragma unroll
            for (int j = 0; j < 4; ++j) { const float n0 = kk[j] * rn, n1 = kk[4 + j] * rn; A0[j] = -n0; A1[j] = -n1; B0[j] = n0 * af[j]; B1[j] = n1 * af[4 + j];
                K0[j] = kf[j] * (1.f + (af[j] - 1.f) * kac[j]); K1[j] = kf[4 + j] * (1.f + (af[4 + j] - 1.f) * kac[4 + j]); R0[j] = rf[j]; R1[j] = rf[4 + j]; }
            LAS float* o = base + pt * 64 + 8 * pc8;
            *(LAS f32x4*)(o) = d0; *(LAS f32x4*)(o + 4) = d1;
            *(LAS f32x4*)(o + 2048) = A0; *(LAS f32x4*)(o + 2048 + 4) = A1;
            *(LAS f32x4*)(o + 4096) = B0; *(LAS f32x4*)(o + 4096 + 4) = B1;
            *(LAS f32x4*)(o + 6144) = K0; *(LAS f32x4*)(o + 6144 + 4) = K1;
            *(LAS f32x4*)(o + 8192) = R0; *(LAS f32x4*)(o + 8192 + 4) = R1;
            base[10240 + pt * 16 + 2 * pc8] = bf_lo(pvw); base[10240 + pt * 16 + 2 * pc8 + 1] = bf_hi(pvw);
        };
        auto flush_y = [&](int ch, int bi) {
            const LAS float* yb = (const LAS float*)(F.lds + RW_Y_OFF + bi * 2048);
            const size_t m = m0 + (size_t)ch * RW_TC + pt;
            f32x2 yv; yv.x = yb[pt * 16 + 2 * pc8]; yv.y = yb[pt * 16 + 2 * pc8 + 1];
            *(f32x2*)(Y + m * DM + colh + rq * 16 + 2 * pc8) = yv;
        };
        if (!scanner) { issue(0); process(0); issue(1); }
        RW_BAR();
        for (int ch = 0; ch < NCH; ++ch) {
            if (scanner) {
                const LAS float* base = (const LAS float*)(F.lds + (ch & 1) * RW_BUF) + 4 * scq;
                const LAS float* vb = (const LAS float*)(F.lds + (ch & 1) * RW_BUF) + 10240 + srow;
                LAS float* yb = (scq == 0) ? (LAS float*)(F.lds + RW_Y_OFF + (ch & 1) * 2048) + srow : (LAS float*)(F.lds + RW_Y_OFF + 4096) + lane;
                f32x4 wv = *(const LAS f32x4*)(base), av = *(const LAS f32x4*)(base + 2048), bv = *(const LAS f32x4*)(base + 4096), kv = *(const LAS f32x4*)(base + 6144), rv = *(const LAS f32x4*)(base + 8192);
                float vv = vb[0];
                f32x4 wv1 = *(const LAS f32x4*)(base + 64), av1 = *(const LAS f32x4*)(base + 64 + 2048), bv1 = *(const LAS f32x4*)(base + 64 + 4096), kv1 = *(const LAS f32x4*)(base + 64 + 6144), rv1 = *(const LAS f32x4*)(base + 64 + 8192);
                float vv1 = vb[16];
                float ypend = 0.f;
#pragma unroll
                for (int t = 0; t < RW_TC; ++t) {
                    const int tn = (t + 2 < RW_TC) ? t + 2 : RW_TC - 1;
                    const LAS float* o = base + tn * 64;
                    const f32x4 nwv = *(const LAS f32x4*)(o), nav = *(const LAS f32x4*)(o + 2048), nbv = *(const LAS f32x4*)(o + 4096), nkv = *(const LAS f32x4*)(o + 6144), nrv = *(const LAS f32x4*)(o + 8192);
                    const float nvv = vb[tn * 16];
                    f32x2 p = s01 * (f32x2){av[0], av[1]}; p = pk_fma(s23, (f32x2){av[2], av[3]}, p);
                    float sa = p.x + p.y, yr = ypend;
                    sa = row16_sum(sa); yr = row16_sum(yr);
                    if (t > 0) yb[(t - 1) * 16] = yr;
                    const f32x2 sa2 = (f32x2){sa, sa}, vv2 = (f32x2){vv, vv};
                    s01 = pk_fma(s01, (f32x2){wv[0], wv[1]}, pk_fma(sa2, (f32x2){bv[0], bv[1]}, vv2 * (f32x2){kv[0], kv[1]}));
                    s23 = pk_fma(s23, (f32x2){wv[2], wv[3]}, pk_fma(sa2, (f32x2){bv[2], bv[3]}, vv2 * (f32x2){kv[2], kv[3]}));
                    f32x2 q = s01 * (f32x2){rv[0], rv[1]}; q = pk_fma(s23, (f32x2){rv[2], rv[3]}, q);
                    ypend = q.x + q.y;
                    wv = wv1; av = av1; bv = bv1; kv = kv1; rv = rv1; vv = vv1;
                    wv1 = nwv; av1 = nav; bv1 = nbv; kv1 = nkv; rv1 = nrv; vv1 = nvv;
                }
                yb[(RW_TC - 1) * 16] = row16_sum(ypend);
            } else {
                if (ch + 1 < NCH) process((ch + 1) & 1);
                if (ch + 2 < NCH) issue(ch + 2);
                if (ch > 0) flush_y(ch - 1, (ch - 1) & 1);
            }
            RW_BAR();
        }
        if (!scanner) flush_y(NCH - 1, (NCH - 1) & 1);
        RW_BAR();
    }
}

__device__ __forceinline__ unsigned cvtpk_s(float lo, float hi) { const f32x2 v = (f32x2){lo, hi}; const bf16x2_t b = __builtin_convertvector(v, bf16x2_t); return __builtin_bit_cast(unsigned, b); }
constexpr int RF_AT = 0, RF_RT = 2048, RF_BF = 4096, RF_KF = 6144, RF_G4 = 8192, RF_GT = 10240, RF_BON = 10496, RF_BYTES = 10560, RF_NCH = SEQ / 16;
constexpr int RF_PIECES = RF_BYTES / 16, RF_V = RF_BYTES, RF_G = RF_BYTES + 2048, RF_SLOT = RF_BYTES + 4096, RF_YL = 8 * RF_SLOT;
__device__ __forceinline__ bf16x8 frag_lo4(f32x4 c) { u32x4 w; w.x = cvtpk_s(c[0], c[1]); w.y = cvtpk_s(c[2], c[3]); w.z = 0u; w.w = 0u; return __builtin_bit_cast(bf16x8, w); }
__device__ __forceinline__ bf16x8 frag_u2(u32x2 v) { u32x4 w; w.x = v.x; w.y = v.y; w.z = 0u; w.w = 0u; return __builtin_bit_cast(bf16x8, w); }
__device__ __forceinline__ f32x4 mfma16(bf16x8 a, bf16x8 b, f32x4 c) { return __builtin_amdgcn_mfma_f32_16x16x32_bf16(a, b, c, 0, 0, 0); }
__device__ __forceinline__ void st16_wt(void* p, u32x4 v) { asm volatile("global_store_dwordx4 %0, %1, off sc1\n\ts_nop 1" :: "v"(p), "v"(v) : "memory"); }
__device__ __forceinline__ void st8_wt(void* p, u32x2 v) { asm volatile("global_store_dwordx2 %0, %1, off sc1" :: "v"(p), "v"(v) : "memory"); }
__device__ __forceinline__ void st4_wt(void* p, float v) { asm volatile("global_store_dword %0, %1, off sc1" :: "v"(p), "v"(v) : "memory"); }
constexpr int RF_ROUND = 24, RF_NROUND = (RF_NCH + RF_ROUND - 1) / RF_ROUND, CW_RFCNT = 12288;
__device__ __forceinline__ float wave_sum_dpp(float x) {
    x = row16_sum(x);
    x += __builtin_bit_cast(float, __builtin_amdgcn_update_dpp(0, __builtin_bit_cast(int, x), 0x142, 0xa, 0xf, false));
    x += __builtin_bit_cast(float, __builtin_amdgcn_update_dpp(0, __builtin_bit_cast(int, x), 0x143, 0xc, 0xf, false));
    return __builtin_bit_cast(float, __builtin_amdgcn_readlane(__builtin_bit_cast(int, x), 63));
}
__device__ __forceinline__ void rwkv_frames_phase(const Frame& F0, const bf16* RKV, const float* DEC, const bf16* AV, const float* k_k, const float* k_a, const float* r_k, unsigned char* FR, int wv0, int nwv, unsigned* cnt) {
    const Frame F = phase_frame(F0); const int lane = F.lane, r16 = lane & 15, g4 = lane >> 4;
    const bf16* Rb = RKV; const bf16* Kb = RKV + (size_t)M * DM;
    LAS bf16* XA = (LAS bf16*)(F.lds + F.wave * 16384); LAS bf16* XB = XA + 1024; LAS bf16* XK = XA + 2048; LAS bf16* XR_ = XA + 3072;
    LAS float* RW_ = (LAS float*)(XA + 4096); LAS float* RAs = RW_ + 1024;
    const f32x4 Z = (f32x4){0.f, 0.f, 0.f, 0.f};
    u32x4 k0, k1, r0, r1, ab0, ab1; f32x4 w0, w1, w2, w3;
#define RA_LOAD(item_) do { const int it_ = (item_), head_ = it_ & 63, c_ = it_ >> 6; \
        const size_t o = ((size_t)(head_ >> 5) * SEQ + (size_t)c_ * 16 + (lane >> 2)) * DM + (head_ & 31) * 64 + (lane & 3) * 16; \
        k0 = ldnt((const u32x4*)(Kb + o)); k1 = ldnt((const u32x4*)(Kb + o + 8)); r0 = ldnt((const u32x4*)(Rb + o)); r1 = ldnt((const u32x4*)(Rb + o + 8)); \
        w0 = ldnt((const f32x4*)(DEC + o)); w1 = ldnt((const f32x4*)(DEC + o + 4)); w2 = ldnt((const f32x4*)(DEC + o + 8)); w3 = ldnt((const f32x4*)(DEC + o + 12)); \
        ab0 = ldnt((const u32x4*)(AV + o)); ab1 = ldnt((const u32x4*)(AV + o + 8)); } while (0)
    constexpr int RA_TOTAL = BATCH * 32 * RF_NCH;
    int prev_round = -1;
    RA_LOAD(min(F.gw - wv0, RA_TOTAL - 1));
    for (int item = F.gw - wv0; item < RA_TOTAL; item += nwv) {
        const int head = item & 63, c = item >> 6, chunk = head * RF_NCH + c, hh = head & 31, col = hh * 64 + lane;
        unsigned char* fr = FR + (size_t)chunk * RF_BYTES;
        const float kkc = k_k[col], kac = k_a[col], rkc = r_k[col]; float bonv = 0.f;
        { const int lt_ = lane >> 2, lc = (lane & 3) * 16;
          *(LAS u32x4*)(XA + lt_ * 64 + lc) = k0; *(LAS u32x4*)(XA + lt_ * 64 + lc + 8) = k1; *(LAS u32x4*)(XR_ + lt_ * 64 + lc) = r0; *(LAS u32x4*)(XR_ + lt_ * 64 + lc + 8) = r1;
          LAS f32x4* wp = (LAS f32x4*)(RW_ + lt_ * 64 + lc); wp[0] = w0; wp[1] = w1; wp[2] = w2; wp[3] = w3;
          LAS f32x4* ap = (LAS f32x4*)(RAs + lt_ * 64 + lc);
          ap[0] = (f32x4){bf_lo(ab0.x), bf_hi(ab0.x), bf_lo(ab0.y), bf_hi(ab0.y)}; ap[1] = (f32x4){bf_lo(ab0.z), bf_hi(ab0.z), bf_lo(ab0.w), bf_hi(ab0.w)};
          ap[2] = (f32x4){bf_lo(ab1.x), bf_hi(ab1.x), bf_lo(ab1.y), bf_hi(ab1.y)}; ap[3] = (f32x4){bf_lo(ab1.z), bf_hi(ab1.z), bf_lo(ab1.w), bf_hi(ab1.w)}; }
        LDS_WAIT(); asm volatile("" ::: "memory");
        RA_LOAD(min(item + nwv, RA_TOTAL - 1));
        float kf[16], rf[16], wv[16], as_[16];
#pragma unroll
        for (int t = 0; t < 16; ++t) { kf[t] = __builtin_bit_cast(float, (unsigned)XA[t * 64 + lane] << 16); rf[t] = __builtin_bit_cast(float, (unsigned)XR_[t * 64 + lane] << 16); wv[t] = RW_[t * 64 + lane]; as_[t] = RAs[t * 64 + lane]; }
        LDS_WAIT(); asm volatile("" ::: "memory");
        float gc = 1.f, bt[16], kt[16];
#pragma unroll
        for (int t = 0; t < 16; ++t) {
            const float kk = kf[t] * kkc, kkn = kk / fmaxf(sqrtf(wave_sum_dpp(kk * kk)), 1e-12f);
            const float gprev = gc; gc *= wv[t]; const float rg = 1.f / gc;
            const float kp = kf[t] * (1.f + (as_[t] - 1.f) * kac); const float bsum = wave_sum_dpp(rf[t] * kp * rkc); bonv = (lane == t) ? bsum : bonv;
            const float at = -kkn * gprev, rt = rf[t] * gc; bt[t] = kkn * as_[t] * rg; kt[t] = kp * rg;
            const bf16 ab = (bf16)f2bf(at), rb = (bf16)f2bf(rt);
            XA[t * 64 + lane] = ab; XB[t * 64 + lane] = (bf16)f2bf(bt[t]); XK[t * 64 + lane] = (bf16)f2bf(kt[t]); XR_[t * 64 + lane] = rb;
        }
        if (prev_round >= 0) {
            asm volatile("s_waitcnt vmcnt(0)" ::: "memory");
            if (lane == 0) __hip_atomic_fetch_add(cnt + 64 * prev_round, 1u, __ATOMIC_RELAXED, __HIP_MEMORY_SCOPE_AGENT); }
        prev_round = c / RF_ROUND;
#pragma unroll
        for (int q = 0; q < 4; ++q) { u32x2 wb, wk; wb.x = pk2(bt[4 * q], bt[4 * q + 1]); wb.y = pk2(bt[4 * q + 2], bt[4 * q + 3]); wk.x = pk2(kt[4 * q], kt[4 * q + 1]); wk.y = pk2(kt[4 * q + 2], kt[4 * q + 3]);
            const int slot = (lane >> 4) * 64 + (lane & 15) + 16 * q;
            st8_wt((u32x2*)(fr + RF_BF) + slot, wb); st8_wt((u32x2*)(fr + RF_KF) + slot, wk); }
        st4_wt((float*)(fr + RF_GT) + lane, gc); if (lane < 16) st4_wt((float*)(fr + RF_BON) + lane, bonv);
        LDS_WAIT(); asm volatile("" ::: "memory");
#pragma unroll
        for (int i = 0; i < 2; ++i) { const int p = lane + 64 * i, t = p >> 3, ch = p & 7, dstp = t * 8 + (ch ^ (t & 7));
            st16_wt((u32x4*)(fr + RF_AT) + dstp, *(const LAS u32x4*)(XA + p * 8)); st16_wt((u32x4*)(fr + RF_RT) + dstp, *(const LAS u32x4*)(XR_ + p * 8)); }
        bf16x8 fa[2], fb[2], fk[2], frr[2];
#pragma unroll
        for (int ks = 0; ks < 2; ++ks) { const int o = r16 * 64 + 32 * ks + 8 * g4;
            fa[ks] = *(const LAS bf16x8*)(XA + o); fb[ks] = *(const LAS bf16x8*)(XB + o); fk[ks] = *(const LAS bf16x8*)(XK + o); frr[ks] = *(const LAS bf16x8*)(XR_ + o); }
        f32x4 CA = mfma16(fb[1], fa[1], mfma16(fb[0], fa[0], Z)), CAk = mfma16(fk[1], fa[1], mfma16(fk[0], fa[0], Z));
        f32x4 CBab = mfma16(fb[1], frr[1], mfma16(fb[0], frr[0], Z)), CBak = mfma16(fk[1], frr[1], mfma16(fk[0], frr[0], Z));
        f32x4 CAT = mfma16(fa[1], fb[1], mfma16(fa[0], fb[0], Z));
        f32x4 ident;
#pragma unroll
        for (int i = 0; i < 4; ++i) { const int s = 4 * g4 + i; CA[i] = (s < r16) ? CA[i] : 0.f; CAk[i] = (s < r16) ? CAk[i] : 0.f; CBab[i] = (s <= r16) ? CBab[i] : 0.f; CBak[i] = (s <= r16) ? CBak[i] : 0.f;
            CAT[i] = (r16 < s) ? CAT[i] : 0.f; ident[i] = (s == r16) ? 1.f : 0.f; }
        const f32x4 CA2 = mfma16(frag_lo4(CAT), frag_lo4(CA), Z), CA2T = mfma16(frag_lo4(CA), frag_lo4(CAT), Z);
        const f32x4 CA4 = mfma16(frag_lo4(CA2T), frag_lo4(CA2), Z), CA4T = mfma16(frag_lo4(CA2), frag_lo4(CA2T), Z);
        const f32x4 CA8 = mfma16(frag_lo4(CA4T), frag_lo4(CA4), Z);
        f32x4 P = CA8 + ident;
        P = mfma16(frag_lo4(CA4T), frag_lo4(P), P); P = mfma16(frag_lo4(CA2T), frag_lo4(P), P); P = mfma16(frag_lo4(CAT), frag_lo4(P), P);
        u32x2* g4p = (u32x2*)(fr + RF_G4);
        { u32x2 w; w.x = cvtpk_s(CAk[0], CAk[1]); w.y = cvtpk_s(CAk[2], CAk[3]); st8_wt(g4p + lane, w); }
        { u32x2 w; w.x = cvtpk_s(P[0], P[1]); w.y = cvtpk_s(P[2], P[3]); st8_wt(g4p + 64 + lane, w); }
        { u32x2 w; w.x = cvtpk_s(CBab[0], CBab[1]); w.y = cvtpk_s(CBab[2], CBab[3]); st8_wt(g4p + 128 + lane, w); }
        { u32x2 w; w.x = cvtpk_s(CBak[0], CBak[1]); w.y = cvtpk_s(CBak[2], CBak[3]); st8_wt(g4p + 192 + lane, w); }
        LDS_WAIT(); asm volatile("" ::: "memory");
    }
    if (prev_round >= 0) { asm volatile("s_waitcnt vmcnt(0)" ::: "memory");
        if (lane == 0) __hip_atomic_fetch_add(cnt + 64 * prev_round, 1u, __ATOMIC_RELAXED, __HIP_MEMORY_SCOPE_AGENT); }
#undef RA_LOAD
}
__device__ __forceinline__ void rwkv_chunk_scan_phase(const Frame& F0, const unsigned char* FR, const bf16* RKV, const bf16* G, bf16* YG, const float* ln_w, const float* ln_b, int nrb, unsigned* cnt) {
    const Frame F = phase_frame(F0); const int lane = F.lane, w = F.wave, tid = F.tid, r16 = lane & 15, g4 = lane >> 4;
    const bf16* Vb = RKV + 2 * (size_t)M * DM;
    const f32x4 Z = (f32x4){0.f, 0.f, 0.f, 0.f};
    for (int head = blockIdx.x; head < BATCH * 32; head += nrb) {
        const int b = head >> 5, hh = head & 31; const size_t m0 = (size_t)b * SEQ;
        const unsigned char* FRh = FR + (size_t)head * RF_NCH * RF_BYTES;
        const bool scanner = w < 4;
        const int lq = w - 4;
        auto ldma = [&](int c) {
            if (c % RF_ROUND == 0) {
                const int k = c / RF_ROUND; const unsigned need = (unsigned)(((RF_NCH - RF_ROUND * k) < RF_ROUND ? (RF_NCH - RF_ROUND * k) : RF_ROUND) * BATCH * 32);
                unsigned sp = 0;
                while ((unsigned)__builtin_amdgcn_readfirstlane((int)__hip_atomic_load(cnt + 64 * k, __ATOMIC_RELAXED, __HIP_MEMORY_SCOPE_AGENT)) < need) { __builtin_amdgcn_s_sleep(4); if (++sp > (1u << 22)) break; }
                __builtin_amdgcn_fence(__ATOMIC_ACQUIRE, "agent"); asm volatile("s_waitcnt vmcnt(0)" ::: "memory");
            }
            const unsigned char* s = FRh + (size_t)c * RF_BYTES; LAS unsigned char* d = F.lds + (c & 7) * RF_SLOT;
#pragma unroll
            for (int i = 0; i < 3; ++i) { const int p0 = lq * 64 + 256 * i;
                if (p0 + lane < RF_PIECES) __builtin_amdgcn_global_load_lds((const GAS unsigned*)(s + (size_t)(p0 + lane) * 16), (LAS unsigned*)(d + p0 * 16), 16, 0, 0); }
            if (lq == 3) {
#pragma unroll
                for (int i = 0; i < 2; ++i) { const int p = 64 * i + lane; const bf16* vs = Vb + (m0 + (size_t)c * 16 + (p >> 3)) * DM + hh * 64 + (p & 7) * 8;
                    __builtin_amdgcn_global_load_lds((const GAS unsigned*)vs, (LAS unsigned*)(d + RF_V + 1024 * i), 16, 0, 0); } }
            if (lq == 2) {
#pragma unroll
                for (int i = 0; i < 2; ++i) { const int p = 64 * i + lane; const bf16* gs = G + (m0 + (size_t)c * 16 + (p >> 3)) * DM + hh * 64 + (p & 7) * 8;
                    __builtin_amdgcn_global_load_lds((const GAS unsigned*)gs, (LAS unsigned*)(d + RF_G + 1024 * i), 16, 0, 0); } } };
        f32x4 st0 = Z, st1 = Z, st2 = Z, st3 = Z;
#define RF_WAIT5() do { if (lq < 2) asm volatile("s_waitcnt vmcnt(12)" ::: "memory"); else if (lq == 2) asm volatile("s_waitcnt vmcnt(20)" ::: "memory"); else asm volatile("s_waitcnt vmcnt(16)" ::: "memory"); } while (0)
        if (!scanner) { for (int c = 0; c < 6; ++c) ldma(c); RF_WAIT5(); }
        RW_BAR();
        int aoff0, aoff1, aoff2, aoff3;
        aoff0 = r16 * 128 + 16 * ((0 + (g4 >> 1)) ^ (r16 & 7)) + 8 * (g4 & 1); aoff1 = r16 * 128 + 16 * ((2 + (g4 >> 1)) ^ (r16 & 7)) + 8 * (g4 & 1);
        aoff2 = r16 * 128 + 16 * ((4 + (g4 >> 1)) ^ (r16 & 7)) + 8 * (g4 & 1); aoff3 = r16 * 128 + 16 * ((6 + (g4 >> 1)) ^ (r16 & 7)) + 8 * (g4 & 1);
#define RF_DECL(S) u32x4 a0##S, a1##S; u32x2 cak##S, cminv##S, bf0##S, bf1##S, bf2##S, bf3##S, kf0##S, kf1##S, kf2##S, kf3##S; f32x4 g0##S, g1##S, g2##S, g3##S; unsigned v01##S, v23##S;
#define RF_FETCH(c_, S) do { const LAS unsigned char* sl = F.lds + ((c_) & 7) * RF_SLOT; \
            const u32x2 x0 = *(const LAS u32x2*)(sl + RF_AT + aoff0), x1 = *(const LAS u32x2*)(sl + RF_AT + aoff1), x2 = *(const LAS u32x2*)(sl + RF_AT + aoff2), x3 = *(const LAS u32x2*)(sl + RF_AT + aoff3); \
            a0##S = (u32x4){x0.x, x0.y, x1.x, x1.y}; a1##S = (u32x4){x2.x, x2.y, x3.x, x3.y}; \
            const LAS u32x2* g4p = (const LAS u32x2*)(sl + RF_G4) + lane; cak##S = g4p[0]; cminv##S = g4p[64]; \
            const LAS u32x2* bfp = (const LAS u32x2*)(sl + RF_BF) + lane; bf0##S = bfp[0]; bf1##S = bfp[64]; bf2##S = bfp[128]; bf3##S = bfp[192]; \
            const LAS u32x2* kfp = (const LAS u32x2*)(sl + RF_KF) + lane; kf0##S = kfp[0]; kf1##S = kfp[64]; kf2##S = kfp[128]; kf3##S = kfp[192]; \
            const LAS f32x4* gtp = (const LAS f32x4*)(sl + RF_GT) + g4; g0##S = gtp[0]; g1##S = gtp[4]; g2##S = gtp[8]; g3##S = gtp[12]; \
            const LAS unsigned short* vl = (const LAS unsigned short*)(sl + RF_V) + (4 * g4) * 64 + 16 * w + r16; \
            v01##S = (unsigned)vl[0] | ((unsigned)vl[64] << 16); v23##S = (unsigned)vl[128] | ((unsigned)vl[192] << 16); } while (0)
#define RF_STEP(c_, S) do { u32x4 vw; vw.x = v01##S; vw.y = v23##S; vw.z = 0u; vw.w = 0u; const bf16x8 vf = __builtin_bit_cast(bf16x8, vw); \
            u32x4 s0w, s1w; s0w.x = cvtpk_s(st0[0], st0[1]); s0w.y = cvtpk_s(st0[2], st0[3]); s0w.z = cvtpk_s(st1[0], st1[1]); s0w.w = cvtpk_s(st1[2], st1[3]); \
            s1w.x = cvtpk_s(st2[0], st2[1]); s1w.y = cvtpk_s(st2[2], st2[3]); s1w.z = cvtpk_s(st3[0], st3[1]); s1w.w = cvtpk_s(st3[2], st3[3]); \
            const bf16x8 sb0 = __builtin_bit_cast(bf16x8, s0w), sb1 = __builtin_bit_cast(bf16x8, s1w); \
            f32x4 RHS = mfma16(__builtin_bit_cast(bf16x8, a0##S), sb0, Z); RHS = mfma16(__builtin_bit_cast(bf16x8, a1##S), sb1, RHS); RHS = mfma16(frag_u2(cak##S), vf, RHS); \
            const f32x4 Wt = mfma16(frag_u2(cminv##S), frag_lo4(RHS), Z); const bf16x8 wfr = frag_lo4(Wt); \
            { f32x4 D = mfma16(frag_u2(bf0##S), wfr, Z); D = mfma16(frag_u2(kf0##S), vf, D); st0 = (st0 + D) * g0##S; } \
            { f32x4 D = mfma16(frag_u2(bf1##S), wfr, Z); D = mfma16(frag_u2(kf1##S), vf, D); st1 = (st1 + D) * g1##S; } \
            { f32x4 D = mfma16(frag_u2(bf2##S), wfr, Z); D = mfma16(frag_u2(kf2##S), vf, D); st2 = (st2 + D) * g2##S; } \
            { f32x4 D = mfma16(frag_u2(bf3##S), wfr, Z); D = mfma16(frag_u2(kf3##S), vf, D); st3 = (st3 + D) * g3##S; } \
            const LAS unsigned char* sly = F.lds + ((c_) & 7) * RF_SLOT;        \
            const u32x2 y0 = *(const LAS u32x2*)(sly + RF_RT + aoff0), y1 = *(const LAS u32x2*)(sly + RF_RT + aoff1), y2 = *(const LAS u32x2*)(sly + RF_RT + aoff2), y3 = *(const LAS u32x2*)(sly + RF_RT + aoff3); \
            const LAS u32x2* g4y = (const LAS u32x2*)(sly + RF_G4) + lane; const u32x2 cbab_ = g4y[128], cbak_ = g4y[192]; \
            f32x4 Yt = mfma16(__builtin_bit_cast(bf16x8, (u32x4){y0.x, y0.y, y1.x, y1.y}), sb0, Z); Yt = mfma16(__builtin_bit_cast(bf16x8, (u32x4){y2.x, y2.y, y3.x, y3.y}), sb1, Yt); Yt = mfma16(frag_u2(cbab_), wfr, Yt); Yt = mfma16(frag_u2(cbak_), vf, Yt); \
            LAS float* yl = (LAS float*)(F.lds + RF_YL + ((c_) & 1) * 4096) + (4 * g4) * 64 + 16 * w + r16; \
            yl[0] = Yt[0]; yl[64] = Yt[1]; yl[128] = Yt[2]; yl[192] = Yt[3]; } while (0)
        const int lt = tid - 256, pt_ = lt >> 4, pcq = lt & 15;
        if (tid < 64) { ((LAS float*)(F.lds + RF_YL + 8192))[tid] = ln_w[hh * 64 + tid]; ((LAS float*)(F.lds + RF_YL + 8192 + 256))[tid] = ln_b[hh * 64 + tid]; }
#define RF_POST(c_) do { const LAS unsigned char* sp = F.lds + ((c_) & 7) * RF_SLOT; \
            const f32x4 y4 = *(const LAS f32x4*)(F.lds + RF_YL + ((c_) & 1) * 4096 + (pt_ * 64 + 4 * pcq) * 4); \
            const f32x4 lnw4 = *(const LAS f32x4*)(F.lds + RF_YL + 8192 + 16 * pcq), lnb4 = *(const LAS f32x4*)(F.lds + RF_YL + 8192 + 256 + 16 * pcq);        \
            const u32x2 vq = *(const LAS u32x2*)(sp + RF_V + (pt_ * 64 + 4 * pcq) * 2), gq = *(const LAS u32x2*)(sp + RF_G + (pt_ * 64 + 4 * pcq) * 2); const float bon = *(const LAS float*)(sp + RF_BON + pt_ * 4); \
            const float mean = row16_sum((y4[0] + y4[1]) + (y4[2] + y4[3])) * (1.f / 64.f); const f32x4 dlt = y4 - mean; \
            const float rstd = 1.f / sqrtf(row16_sum((dlt[0] * dlt[0] + dlt[1] * dlt[1]) + (dlt[2] * dlt[2] + dlt[3] * dlt[3])) * (1.f / 64.f) + 64e-5f); \
            const f32x4 vv = (f32x4){bf_lo(vq.x), bf_hi(vq.x), bf_lo(vq.y), bf_hi(vq.y)}, gg = (f32x4){bf_lo(gq.x), bf_hi(gq.x), bf_lo(gq.y), bf_hi(gq.y)}; \
            const f32x4 o4 = (dlt * rstd * lnw4 + lnb4 + vv * bon) * gg; u32x2 ow; ow.x = pk2(o4[0], o4[1]); ow.y = pk2(o4[2], o4[3]); \
            *(GAS u32x2*)(YG + (m0 + (size_t)(c_) * 16 + pt_) * DM + hh * 64 + 4 * pcq) = ow; } while (0)
        RF_DECL(A) RF_DECL(B)
        if (scanner) RF_FETCH(0, A);
        for (int c = 0; c < RF_NCH; c += 2) {
            if (scanner) { RF_FETCH(c + 1, B); RF_STEP(c, A); }
            else { if (c > 0) RF_POST(c - 1); if (c + 6 < RF_NCH) { ldma(c + 6); RF_WAIT5(); } else asm volatile("s_waitcnt vmcnt(0)" ::: "memory"); }
            RW_BAR();
            if (scanner) { if (c + 2 < RF_NCH) RF_FETCH(c + 2, A); RF_STEP(c + 1, B); }
            else { RF_POST(c); if (c + 7 < RF_NCH) { ldma(c + 7); RF_WAIT5(); } else asm volatile("s_waitcnt vmcnt(0)" ::: "memory"); }
            RW_BAR();
        }
        if (!scanner) RF_POST(RF_NCH - 1);
        RW_BAR();
#undef RF_POST
#undef RF_DECL
#undef RF_FETCH
#undef RF_STEP
    }
}

__device__ __forceinline__ void rwkv_post_phase(const Frame& F0, const bf16* RKV, const float* AV, const bf16* G, const float* Y, bf16* YG,
                                                const float* k_a, const float* r_k, const float* ln_w, const float* ln_b) {
    const Frame F = phase_frame(F0);
    const bf16* Rb = RKV; const bf16* Kb = RKV + (size_t)M * DM; const bf16* Vb = RKV + 2 * (size_t)M * DM;
    const int gt = blockIdx.x * 512 + F.tid, NT = F.G * 512;
    for (int idx = gt; idx < M * 256; idx += NT) {
        const size_t m = (size_t)(idx >> 8); const int col = (idx & 255) * 8;
        const size_t off = m * DM + col;
        const f32x4 y0 = *(const f32x4*)(Y + off), y1 = *(const f32x4*)(Y + off + 4), a0 = *(const f32x4*)(AV + off), a1 = *(const f32x4*)(AV + off + 4); const u32x4 gw = *(const u32x4*)(G + off);
        const u32x4 rw = *(const u32x4*)(Rb + off), kw = *(const u32x4*)(Kb + off), vw = *(const u32x4*)(Vb + off);
        float y[8], a[8], gg[8], r[8], k[8], v[8];
#pragma unroll
        for (int j = 0; j < 4; ++j) { y[j] = y0[j]; y[4 + j] = y1[j]; a[j] = a0[j]; a[4 + j] = a1[j]; gg[2 * j] = bf_lo(gw[j]); gg[2 * j + 1] = bf_hi(gw[j]);
            r[2 * j] = bf_lo(rw[j]); r[2 * j + 1] = bf_hi(rw[j]); k[2 * j] = bf_lo(kw[j]); k[2 * j + 1] = bf_hi(kw[j]); v[2 * j] = bf_lo(vw[j]); v[2 * j + 1] = bf_hi(vw[j]); }
        float s = 0.f, bon = 0.f;
#pragma unroll
        for (int j = 0; j < 8; ++j) { s += y[j]; const float kp = k[j] * (1.f + (a[j] - 1.f) * k_a[col + j]); bon += r[j] * kp * r_k[col + j]; }
        s += __shfl_xor(s, 1); s += __shfl_xor(s, 2); s += __shfl_xor(s, 4);
        bon += __shfl_xor(bon, 1); bon += __shfl_xor(bon, 2); bon += __shfl_xor(bon, 4);
        const float mean = s * (1.f / 64.f); float q = 0.f;
#pragma unroll
        for (int j = 0; j < 8; ++j) { const float dlt = y[j] - mean; q += dlt * dlt; }
        q += __shfl_xor(q, 1); q += __shfl_xor(q, 2); q += __shfl_xor(q, 4);
        const float rstd = 1.f / sqrtf(q * (1.f / 64.f) + 64e-5f);
        u32x4 o;
#pragma unroll
        for (int j = 0; j < 4; ++j) { float e0 = ((y[2 * j] - mean) * rstd * ln_w[col + 2 * j] + ln_b[col + 2 * j] + bon * v[2 * j]) * gg[2 * j];
            float e1 = ((y[2 * j + 1] - mean) * rstd * ln_w[col + 2 * j + 1] + ln_b[col + 2 * j + 1] + bon * v[2 * j + 1]) * gg[2 * j + 1]; o[j] = pk2(e0, e1); }
        *(u32x4*)(YG + off) = o;
    }
}

constexpr int PH_PER_LAYER = 12, PH_FINAL = DEPTH * PH_PER_LAYER, PH_END = PH_FINAL + 1;
struct Args { const float* in[34]; float* out; unsigned char* ws; int ph_lo, ph_hi; };
#define IN(k) (lo <= (k) && (k) < hi)
#define SEAM(k) do { if ((k) > lo) xcd_barrier(bar); } while (0)
#define PH_BEGIN int z_ = 0; asm volatile("" : "+s"(z_)); unsigned char* ws = args.ws + (size_t)(unsigned)z_;     int bid = blockIdx.x; asm volatile("" : "+s"(bid)); \
    float* out = args.out; bf16* H = (bf16*)(ws + WS_H); bf16* XR = (bf16*)(ws + WS_XR); unsigned char* big = ws + WS_BIG; LAS unsigned char* ring = F.lds; (void)H; (void)XR; (void)big; (void)ring; (void)out; (void)bid
#define AIN(k) (args.in[(k) + z_])
#define SSQ(k) ((pg8::ssq_t*)(ws + WS_CTL + CTL_SSQ) + (size_t)(k) * M)
template <int layer> __device__ __forceinline__ void layer_body(const Args& args, const Frame& F, const XcdBarrier& bar, const int lo, const int hi) {
        constexpr int kind = layer % 3, pb = layer * PH_PER_LAYER, li = layer / 3;
#define CVT_MIX_ATTN(L) do { \
            cvt_mat(F, AIN(4) + (size_t)((L) / 3) * DM * NQKV, NQKV, DM, NQKV, DM, NQKV, (bf16*)(ws + WS_W + W_QKV), DM, 0, 0, AIN(1) + (size_t)(L) * DM, (L) == 0 ? 0 : 1, 0);     \
            cvt_mat(F, AIN(5) + (size_t)((L) / 3) * DM * DM, DM, DM, DM, DM, DM, (bf16*)(ws + WS_W + W_AO), DM, 0, 0, nullptr, 0, 0); } while (0)
#define CVT_MIX_S5(L) do { \
            cvt_mat(F, AIN(6) + (size_t)((L) / 3) * DM * DM, DM, DM, DM, DM, DM, (bf16*)(ws + WS_W + W_SIN), DM, 0, 0, AIN(1) + (size_t)(L) * DM, 1, 0); \
            cvt_mat(F, AIN(15) + (size_t)((L) / 3) * DM * 2 * DM, 2 * DM, DM, 2 * DM, DM, 2 * DM, (bf16*)(ws + WS_W + W_SOUT), DM, 0, 0, nullptr, 0, 1); \
            __syncthreads(); \
            s5_precompute(F, AIN(7) + (size_t)((L) / 3) * 128, AIN(8) + (size_t)((L) / 3) * 8192, AIN(9) + (size_t)((L) / 3) * 8192, AIN(10) + (size_t)((L) / 3) * 131072, AIN(11) + (size_t)((L) / 3) * 131072, \
                          AIN(12) + (size_t)((L) / 3) * 131072, AIN(13) + (size_t)((L) / 3) * 131072, AIN(14) + (size_t)((L) / 3) * 2048, (bf16*)(ws + WS_W + W_SY), (bf16*)(ws + WS_W + W_SF)); \
            __syncthreads(); } while (0)
#define CVT_MLP(L) do { \
            cvt_mat(F, AIN(32) + (size_t)(L) * DM * FF, FF, DM, FF, DM, FF, (bf16*)(ws + WS_W + W_M1), DM, 0, 0, AIN(2) + (size_t)(L) * DM, 1, 0); \
            cvt_mat(F, AIN(33) + (size_t)(L) * FF * DM, DM, FF, DM, FF, DM, (bf16*)(ws + WS_W + W_M2), FF, 0, 0, nullptr, 0, 0); } while (0)
        constexpr bool own0 = (layer == 0 || kind == 2), next_own0 = (layer + 1 >= DEPTH) || (layer + 1 == 0 || (layer + 1) % 3 == 2);
        if (own0 && IN(pb + 0)) { SEAM(pb + 0); PH_BEGIN; REP(1) {
            if (kind == 0) CVT_MIX_ATTN(layer);
            else if (kind == 1) CVT_MIX_S5(layer);
            else {
                bf16* Wf = (bf16*)(ws + WS_W + W_RF);
                for (int j = 0; j < 6; ++j) {
                    const float* wsrc = j < 3 ? AIN(17) + ((size_t)li * 3 + j) * DM * DM : (j == 3 ? AIN(19) + (size_t)li * DM * 96 : (j == 4 ? AIN(22) + (size_t)li * DM * 96 : AIN(24) + (size_t)li * DM * 256));
                    const int nsrc = j < 3 ? DM : (j < 5 ? 96 : 256), npad = j < 3 ? DM : 256, drow = j < 3 ? j * DM : 6144 + (j - 3) * 256;
                    cvt_mat(F, wsrc, nsrc, DM, nsrc, DM, npad, Wf, DM, drow, 0, nullptr, 0, 0);
                }
                for (int j = 0; j < 3; ++j) {
                    const float* wsrc = j == 0 ? AIN(20) + (size_t)li * 96 * DM : (j == 1 ? AIN(23) + (size_t)li * 96 * DM : AIN(25) + (size_t)li * 256 * DM);
                    cvt_mat(F, wsrc, DM, j < 2 ? 96 : 256, DM, 256, DM, (bf16*)(ws + WS_W + W_R2W + (size_t)j * MiB), 256, 0, 0, nullptr, 0, 0);
                }
                cvt_mat(F, AIN(31) + (size_t)li * DM * DM, DM, DM, DM, DM, DM, (bf16*)(ws + WS_W + W_RO), DM, 0, 0, nullptr, 0, 0);
            }
            CVT_MLP(layer);
            if (kind == 2) norm_rows_rwkv(F, XR, AIN(1) + (size_t)layer * DM, AIN(16) + (size_t)li * 6 * DM, (bf16*)(big + B_X6));
            else if (layer == 0) norm_rows(F, AIN(0), false, AIN(1) + (size_t)layer * DM, H, nullptr, 0);
        } }
        if (kind == 0) {
            if (IN(pb + 1)) { SEAM(pb + 1); PH_BEGIN;
                if (!own0) { CVT_MLP(layer); __syncthreads(); }
                pg8::Gemm g{layer == 0 ? H : XR, (const bf16*)(ws + WS_W + W_QKV), M, NQKV, DM, DM, DM}; pg8::StaticOrder S; S.init(M, NQKV, F.G, bid);
                pg8::EpiBf16<0> E{(bf16*)(big + B_QKV), NQKV, layer == 0 ? (const pg8::ssq_t*)nullptr : (const pg8::ssq_t*)SSQ((2 * layer + 7) % 8)}; REP(2) pg8::gemm_phase(ring, F.wave, g, S, E); }
            if (IN(pb + 2)) { SEAM(pb + 2); PH_BEGIN;
#ifndef NO_ATTN
                REP(3) attn_phase(F, (const bf16*)(big + B_QKV), (float*)(big + B_LSE), (bf16*)(big + B_OG));
#endif
            }
            if (IN(pb + 3)) { SEAM(pb + 3); PH_BEGIN; REP(1) attn_merge_phase(F, (const bf16*)(big + B_OG), (const float*)(big + B_LSE), H); }
            if (IN(pb + 4)) { SEAM(pb + 4); PH_BEGIN;
                pg8::Gemm g{H, (const bf16*)(ws + WS_W + W_AO), M, DM, DM, DM, DM}; pg8::StaticOrder S; S.init(M, DM, F.G, bid);
                pg8::EpiResB<layer == 0> E{layer == 0 ? (const void*)AIN(0) : (const void*)XR, XR, SSQ(2 * layer)};  pg8::gemm_phase(ring, F.wave, g, S, E); }
        } else if (kind == 1) {
            if (IN(pb + 1)) { SEAM(pb + 1); PH_BEGIN;
                if (!own0) { CVT_MLP(layer); __syncthreads(); }
                pg8::Gemm g{XR, (const bf16*)(ws + WS_W + W_SIN), M, DM, DM, DM, DM}; pg8::StaticOrder S; S.init(M, DM, F.G, bid);
                pg8::EpiS5U16 E{(bf16*)(big + B_U), (const pg8::ssq_t*)SSQ((2 * layer + 7) % 8)}; REP(2) pg8::gemm_phase(ring, F.wave, g, S, E); }
            if (IN(pb + 2)) { SEAM(pb + 2); PH_BEGIN; REP(0) {
                for (int pair = bid; pair < 256; pair += F.G) { pg8::PairOrder S{pair}; bf16* U16 = (bf16*)(big + B_U); float* XO = (float*)(big + B_XO);
                    { pg8::Gemm g{U16, (const bf16*)(ws + WS_W + W_SF), 131072, 256, 256, 512, 256}; pg8::EpiS5F E{XO}; pg8::gemm_phase(ring, F.wave, g, S, E); }
                    VM_WAIT(); __syncthreads(); __builtin_amdgcn_fence(__ATOMIC_ACQUIRE, "agent"); VM_WAIT();
                    s5_chunk_scan(phase_frame(F), pair, XO, U16, AIN(7) + (size_t)li * 128, AIN(8) + (size_t)li * 8192, AIN(9) + (size_t)li * 8192);
                    VM_WAIT(); __syncthreads(); __builtin_amdgcn_fence(__ATOMIC_ACQUIRE, "agent"); VM_WAIT();
                    { pg8::Gemm g{U16, (const bf16*)(ws + WS_W + W_SY), 131072, 256, 384, 512, 384}; pg8::EpiS5Y E{H}; pg8::gemm_phase(ring, F.wave, g, S, E); } } } }
            if (IN(pb + 3)) { SEAM(pb + 3); PH_BEGIN;
                pg8::Gemm g{H, (const bf16*)(ws + WS_W + W_SOUT), M, 2 * DM, DM, DM, DM}; pg8::StaticOrder S; S.init(M, 2 * DM, F.G, bid);
                pg8::EpiGluRes E{XR, SSQ(2 * layer)};  pg8::gemm_phase(ring, F.wave, g, S, E); }
        } else {
            if (IN(pb + 1)) { SEAM(pb + 1); PH_BEGIN;
                pg8::Gemm g{(const bf16*)(big + B_X6), (const bf16*)(ws + WS_W + W_RF), M, NRW1, DM, DM, DM}; pg8::RwkvOrder S; S.init(M, NRW1, F.G, bid);
                pg8::EpiRwkv1 E{(bf16*)(big + B_RKV), (bf16*)(big + B_LORA)}; REP(2) pg8::gemm_phase(ring, F.wave, g, S, E); }
            if (IN(pb + 2)) { SEAM(pb + 2); PH_BEGIN;
                pg8::StaticOrder S; S.init(M, DM, F.G, bid); const bf16* LORA = (const bf16*)(big + B_LORA); REP(2) {
                { pg8::Gemm g{LORA, (const bf16*)(ws + WS_W + W_R2W), M, DM, 256, 768, 256}; pg8::EpiBiasF32<1> E{(float*)(big + B_DEC), AIN(18) + (size_t)li * DM}; pg8::gemm_phase(ring, F.wave, g, S, E); }
                { pg8::Gemm g{LORA + 256, (const bf16*)(ws + WS_W + W_R2A), M, DM, 256, 768, 256}; pg8::EpiSigBf16 E{(bf16*)(big + B_AV), DM, AIN(21) + (size_t)li * DM}; pg8::gemm_phase(ring, F.wave, g, S, E); }
                { pg8::Gemm g{LORA + 512, (const bf16*)(ws + WS_W + W_R2G), M, DM, 256, 768, 256}; pg8::EpiBf16<0> E{(bf16*)(big + B_G), DM, nullptr}; pg8::gemm_phase(ring, F.wave, g, S, E); } } }
            if (IN(pb + 3)) { SEAM(pb + 3); PH_BEGIN;
                const int nrb = F.G >= 128 ? 64 : (F.G >= 8 ? F.G / 4 : 1); unsigned* cnt = (unsigned*)(ws + WS_CTL) + CW_RFCNT;
                if ((int)blockIdx.x < nrb) rwkv_chunk_scan_phase(F, big + B_FR, (const bf16*)(big + B_RKV), (const bf16*)(big + B_G), H, AIN(29) + (size_t)li * DM, AIN(30) + (size_t)li * DM, nrb, cnt);
                else rwkv_frames_phase(F, (const bf16*)(big + B_RKV), (const float*)(big + B_DEC), (const bf16*)(big + B_AV), AIN(26) + (size_t)li * DM, AIN(27) + (size_t)li * DM, AIN(28) + (size_t)li * DM, big + B_FR, nrb * NWAVES, (F.G - nrb) * NWAVES, cnt); }
            if (IN(pb + 6)) { SEAM(pb + 6); PH_BEGIN;
                pg8::Gemm g{H, (const bf16*)(ws + WS_W + W_RO), M, DM, DM, DM, DM}; pg8::StaticOrder S; S.init(M, DM, F.G, bid);
                pg8::EpiResB<false> E{(const void*)XR, XR, SSQ(2 * layer)}; pg8::gemm_phase(ring, F.wave, g, S, E); }
        }
        if (IN(pb + 7)) { SEAM(pb + 7); PH_BEGIN;
            pg8::Gemm g{XR, (const bf16*)(ws + WS_W + W_M1), M, FF, DM, DM, DM}; pg8::StaticOrder S; S.init(M, FF, F.G, bid);
            pg8::EpiBf16<1> E{(bf16*)(big + B_HID), FF, (const pg8::ssq_t*)SSQ(2 * layer)}; REP(2) pg8::gemm_phase(ring, F.wave, g, S, E); }
        if (IN(pb + 8)) { SEAM(pb + 8); PH_BEGIN;
            if (!next_own0) { if ((layer + 1) % 3 == 0) CVT_MIX_ATTN(layer + 1); else CVT_MIX_S5(layer + 1); __syncthreads(); }
            pg8::Gemm g{(const bf16*)(big + B_HID), (const bf16*)(ws + WS_W + W_M2), M, DM, FF, FF, FF}; pg8::StaticOrder S; S.init(M, DM, F.G, bid);
            pg8::EpiResB<false> E{(const void*)XR, XR, SSQ(2 * layer + 1)};  pg8::gemm_phase(ring, F.wave, g, S, E); }
    }
__global__ void __launch_bounds__(NWAVES * 64, 2) trunk_fwd(Args args) {
    extern __shared__ __attribute__((aligned(16))) unsigned char lds_raw[];
    Frame F;
    F.lds = (LAS unsigned char*)lds_raw;
    F.wave = __builtin_amdgcn_readfirstlane((int)threadIdx.x >> 6); F.lane = 0; F.tid = 0;
    F.G = gridDim.x; F.gw = blockIdx.x * NWAVES + F.wave; F.NGW = F.G * NWAVES;
    volatile LAS unsigned* MISC = (volatile LAS unsigned*)(F.lds + MISC_OFF);
    if (threadIdx.x < 16) MISC[threadIdx.x] = 0u;
    __syncthreads();
    unsigned* ctl = (unsigned*)(args.ws + WS_CTL);
    const int lo = args.ph_lo, hi = args.ph_hi;
    XcdBarrier bar; bar.bar = ctl + CW_BAR; bar.x = 0; bar.st = MISC + 8; bar.wave = F.wave;
    if (hi - lo > 1) bar = xcd_barrier_post(ctl + CW_BAR, MISC + 8, F.wave);
    layer_body<0>(args, F, bar, lo, hi); layer_body<1>(args, F, bar, lo, hi); layer_body<2>(args, F, bar, lo, hi); layer_body<3>(args, F, bar, lo, hi);
    if (IN(PH_FINAL)) { SEAM(PH_FINAL); PH_BEGIN; norm_rows(F, XR, true, AIN(3), nullptr, out, 2); }
#undef PH_BEGIN
#undef AIN
#undef IN
#undef SEAM
}

static bool phase_used(int p) {
    if (p == PH_FINAL) return true;
    const int layer = p / PH_PER_LAYER, slot = p % PH_PER_LAYER, kind = layer % 3;
    if (slot == 0) return layer == 0 || kind == 2;
    if (slot >= 7 && slot <= 8) return true;
    if (slot >= 1 && slot <= 6) { if (kind == 2) return slot <= 3 || slot == 6; const int n = kind == 0 ? 4 : 3; return slot <= n; }
    return false;
}
extern "C" void kernel_launch(void* const* d_in, const int* in_sizes, int n_in, void* d_out, int out_size, void* d_ws, size_t ws_size, hipStream_t stream) {
    static int grid = 0;
    if (grid == 0) {
        if (n_in != 34 || in_sizes[0] != M * DM || out_size != M * DM || ws_size < WS_END) { fprintf(stderr, "kernel_launch: unexpected shapes / workspace (n_in %d, ws %zu, need %zu); nothing launched\n", n_in, ws_size, (size_t)WS_END); grid = -1; return; }
        int dev = 0, cus = 0, per_cu = 0;
        if (hipGetDevice(&dev) != hipSuccess || hipDeviceGetAttribute(&cus, hipDeviceAttributeMultiprocessorCount, dev) != hipSuccess) { grid = -1; return; }
        if (hipFuncSetAttribute((const void*)trunk_fwd, hipFuncAttributeMaxDynamicSharedMemorySize, LDS_BYTES) != hipSuccess) { fprintf(stderr, "kernel_launch: hipFuncSetAttribute failed\n"); grid = -1; return; }
        if (hipOccupancyMaxActiveBlocksPerMultiprocessor(&per_cu, (const void*)trunk_fwd, NWAVES * 64, LDS_BYTES) != hipSuccess || per_cu < 1) { fprintf(stderr, "kernel_launch: occupancy query says %d blocks per CU\n", per_cu); (void)hipGetLastError(); grid = -1; return; }
        grid = cus;
    }
    if (grid < 0) return;
    if (hipMemsetAsync((char*)d_ws + WS_CTL, 0, CTL_ZERO_BYTES, stream) != hipSuccess) return;
    Args a{};
    for (int i = 0; i < 34; ++i) a.in[i] = (const float*)d_in[i];
    a.out = (float*)d_out; a.ws = (unsigned char*)d_ws;
#if MK_N_LAUNCHES == 1
    a.ph_lo = 0; a.ph_hi = PH_END;
    hipLaunchKernelGGL(trunk_fwd, dim3(grid), dim3(NWAVES * 64), LDS_BYTES, stream, a);
#else
    for (int p = 0; p < PH_END; ++p) { if (!phase_used(p)) continue; a.ph_lo = p; a.ph_hi = p + 1;
        hipLaunchKernelGGL(trunk_fwd, dim3(grid), dim3(NWAVES * 64), LDS_BYTES, stream, a); }
#endif
    const hipError_t le = hipPeekAtLastError();
    if (le != hipSuccess) fprintf(stderr, "kernel_launch: launch failed: %s\n", hipGetErrorName(le));
}
```
